# Optimizing an MI355X kernel written in HIP

```python
import jax, jax.numpy as jnp
from jax import lax
import numpy as np

D_MODEL = 2048
BATCH = 4
SEQ = 4096
DEPTH = 1

PLE_DIM = 256
D_FF = 4 * D_MODEL
EPS = 1e-6
GLA_HEADS = 4
GLA_KEY_W = D_MODEL // 4
GLA_VAL_W = D_MODEL // 2
GLA_DK = GLA_KEY_W // GLA_HEADS
GLA_DV = GLA_VAL_W // GLA_HEADS
GATE_RANK = 16
GATE_TAU = 16.0
CHUNK = 64
SB_W = D_MODEL // 2
SB_DH = 128
SB_HEADS = SB_W // SB_DH
SB_BLOCK = 128
IN_SPLITS = (GLA_KEY_W, GLA_KEY_W, GLA_VAL_W, GATE_RANK, GLA_VAL_W,
             SB_W, SB_W, SB_W, D_MODEL, D_MODEL)
IN_W = sum(IN_SPLITS)

kernel_name = "hybrid_gla_stickbreaking_gated_block"


def rmsnorm(h, gain):
    hf = h.astype(jnp.float32)
    hf = hf * lax.rsqrt(jnp.mean(hf * hf, axis=-1, keepdims=True) + EPS)
    return (hf * gain.astype(jnp.float32)).astype(h.dtype)


def split_cols(z, sizes):
    offs = np.cumsum(sizes)[:-1].tolist()
    return jnp.split(z, offs, axis=-1)


def gla_chunked(q, k, v, log_a):
    B, T, H, dk = q.shape
    dv = v.shape[-1]
    N = T // CHUNK

    def chunk(z):
        return z.astype(jnp.float32).reshape(B, N, CHUNK, H, z.shape[-1]).transpose(1, 0, 3, 2, 4)

    qc, kc, vc, lac = chunk(q), chunk(k), chunk(v), chunk(log_a)
    b = jnp.cumsum(lac, axis=3)
    b_last = b[:, :, :, -1:, :]
    q_dec = qc * (dk ** -0.5) * jnp.exp(b)
    k_intra = kc * jnp.exp(-b)
    k_state = kc * jnp.exp(b_last - b)
    decay = jnp.exp(b_last[:, :, :, 0, :])

    causal = jnp.tril(jnp.ones((CHUNK, CHUNK), dtype=bool))
    scores = jnp.einsum('nbhcd,nbhsd->nbhcs', q_dec, k_intra)
    scores = jnp.where(causal, scores, 0.0)
    o_intra = jnp.einsum('nbhcs,nbhse->nbhce', scores, vc)

    def step(S, inp):
        qd, ks, vv, dec = inp
        o = jnp.einsum('bhcd,bhde->bhce', qd, S)
        S = dec[..., None] * S + jnp.einsum('bhcd,bhce->bhde', ks, vv)
        return S, o

    S0 = jnp.zeros((B, H, dk, dv), jnp.float32)
    _, o_inter = lax.scan(step, S0, (q_dec, k_state, vc, decay))
    o = o_intra + o_inter
    return o.transpose(1, 0, 3, 2, 4).reshape(B, T, H, dv)


def stick_breaking_attention(q, k, v):
    T = q.shape[2]
    d = q.shape[-1]
    scale = d ** -0.5
    qf, kf, vf = q.astype(jnp.float32), k.astype(jnp.float32), v.astype(jnp.float32)
    outs = []
    for i in range(T // SB_BLOCK):
        q0, kend = i * SB_BLOCK, (i + 1) * SB_BLOCK
        qb = qf[:, :, q0:kend]
        kb, vb = kf[:, :, :kend], vf[:, :, :kend]
        z = jnp.einsum('bhqd,bhkd->bhqk', qb, kb) * scale
        t_idx = q0 + jnp.arange(SB_BLOCK)
        s_idx = jnp.arange(kend)
        mask = s_idx[None, :] < t_idx[:, None]
        log_beta = jax.nn.log_sigmoid(z)
        log_1mb = jnp.where(mask, jax.nn.log_sigmoid(-z), 0.0)
        suffix = lax.cumsum(log_1mb, axis=3, reverse=True) - log_1mb
        A = jnp.where(mask, jnp.exp(log_beta + suffix), 0.0)
        outs.append(jnp.einsum('bhqk,bhkd->bhqd', A, vb))
    return jnp.concatenate(outs, axis=2)


def mixer_block(h, w_in, w_gate_up, b_gate, gla_norm, w_branch_gla, w_branch_sb, w_out):
    B, T, _ = h.shape
    z = h @ w_in
    (gq, gk, gv, g_lr, g_out, sq, sk, sv, gate_a, gate_b) = split_cols(z, IN_SPLITS)

    log_a = jax.nn.log_sigmoid((g_lr @ w_gate_up + b_gate).astype(jnp.float32)) / GATE_TAU
    o_a = gla_chunked(gq.reshape(B, T, GLA_HEADS, GLA_DK),
                      gk.reshape(B, T, GLA_HEADS, GLA_DK),
                      gv.reshape(B, T, GLA_HEADS, GLA_DV),
                      log_a.reshape(B, T, GLA_HEADS, GLA_DK))
    o_a = rmsnorm(o_a, gla_norm).reshape(B, T, GLA_VAL_W).astype(h.dtype)
    o_a = o_a * jax.nn.silu(g_out)
    y_a = o_a @ w_branch_gla

    def heads(t):
        return t.reshape(B, T, SB_HEADS, SB_DH).transpose(0, 2, 1, 3)
    o_b = stick_breaking_attention(heads(sq), heads(sk), heads(sv))
    o_b = o_b.transpose(0, 2, 1, 3).reshape(B, T, SB_W).astype(h.dtype)
    y_b = o_b @ w_branch_sb

    y = jax.nn.sigmoid(gate_a) * y_a + jax.nn.sigmoid(gate_b) * y_b
    return y @ w_out


def setup_inputs(seed: int = 0) -> dict:
    key = jax.random.key(seed)
    ks = jax.random.split(key, 20)

    def w(k, shape, fan_in):
        return jax.random.normal(k, shape, jnp.float32) * (fan_in ** -0.5)

    def gain(k, n):
        return 1.0 + 0.02 * jax.random.normal(k, (DEPTH, n), jnp.float32)

    return {
        "x": jax.random.normal(ks[0], (BATCH, SEQ, D_MODEL), jnp.float32),
        "p": jax.random.normal(ks[1], (DEPTH, BATCH, SEQ, PLE_DIM), jnp.float32),
        "norm_mix_pre": gain(ks[2], D_MODEL),
        "norm_mix_post": gain(ks[3], D_MODEL),
        "w_in": w(ks[4], (DEPTH, D_MODEL, IN_W), D_MODEL),
        "w_gate_up": w(ks[5], (DEPTH, GATE_RANK, GLA_KEY_W), GATE_RANK),
        "b_gate": 0.1 * jax.random.normal(ks[6], (DEPTH, GLA_KEY_W), jnp.float32),
        "gla_norm": gain(ks[7], GLA_DV),
        "w_branch_gla": w(ks[8], (DEPTH, GLA_VAL_W, D_MODEL), GLA_VAL_W),
        "w_branch_sb": w(ks[9], (DEPTH, SB_W, D_MODEL), SB_W),
        "w_out": w(ks[10], (DEPTH, D_MODEL, D_MODEL), D_MODEL),
        "norm_mlp_pre": gain(ks[11], D_MODEL),
        "norm_mlp_post": gain(ks[12], D_MODEL),
        "w_mlp_up": w(ks[13], (DEPTH, D_MODEL, D_FF), D_MODEL),
        "w_mlp_down": w(ks[14], (DEPTH, D_FF, D_MODEL), D_FF),
        "norm_ple": gain(ks[15], D_MODEL),
        "w_ple_gate": w(ks[16], (DEPTH, D_MODEL, D_MODEL), D_MODEL),
        "w_ple_proj": w(ks[17], (DEPTH, PLE_DIM, D_MODEL), PLE_DIM),
    }


def reference(x, p, norm_mix_pre, norm_mix_post, w_in, w_gate_up, b_gate, gla_norm,
              w_branch_gla, w_branch_sb, w_out, norm_mlp_pre, norm_mlp_post,
              w_mlp_up, w_mlp_down, norm_ple, w_ple_gate, w_ple_proj):
    h = x
    for i in range(DEPTH):
        u = rmsnorm(h, norm_mix_pre[i])
        m = mixer_block(u, w_in[i], w_gate_up[i], b_gate[i], gla_norm[i],
                        w_branch_gla[i], w_branch_sb[i], w_out[i])
        h = h + rmsnorm(m, norm_mix_post[i])
        u = rmsnorm(h, norm_mlp_pre[i])
        f = jnp.square(jax.nn.relu(u @ w_mlp_up[i])) @ w_mlp_down[i]
        h = h + rmsnorm(f, norm_mlp_post[i])
        e = p[i] @ w_ple_proj[i]
        g = jax.nn.sigmoid(rmsnorm(h, norm_ple[i]) @ w_ple_gate[i])
        h = h + g * e
    return h
```

```cpp
#include <hip/hip_runtime.h>
#include <hip/hip_cooperative_groups.h>
#include <cstdio>
#include <cstdint>
namespace cg = cooperative_groups;
namespace pg8 {
#define PG8_LAS __attribute__((address_space(3)))
typedef unsigned short bf16_t;
typedef short bf16x8 __attribute__((ext_vector_type(8)));
typedef float f32x4 __attribute__((ext_vector_type(4)));
typedef unsigned u32x4 __attribute__((ext_vector_type(4)));
constexpr int BM = 256, BK = 64, HALF = 128, HTB = HALF * BK * 2  , STAGE_BYTES = 8 * HTB, NXCD = 8, WGM = 8;

__host__ __device__ __forceinline__ int lds_byte(int r, int c) { const int st = (r >> 4) * 2 + (c >> 5), rr = r & 15, cc = c & 31, ob = rr * 64 + cc * 2; return st * 1024 + (ob ^ (((ob >> 9) & 1) << 5)); }
__host__ __device__ __forceinline__ void stage_rc(int b, int& R, int& C) { const int st = b / 1024, sb = b % 1024, swz = sb ^ (((sb >> 9) & 1) << 5); R = (st >> 1) * 16 + swz / 64; C = (st & 1) * 32 + (swz % 64) / 2; }
__host__ __device__ __forceinline__ int perm32(int rho) { const int n = rho >> 4, i = rho & 15; return 8 * (i >> 2) + 4 * n + (i & 3); }

struct Unit { int pm, pn; };
struct Gemm { const bf16_t* A; const bf16_t* Bt; int M, N, K; };

struct StaticOrder {
    int nM, nN, nwg, G, c;
    __host__ __device__ void init(int M, int N, int G_, int c_) { nM = M / BM; nN = N / BM; nwg = nM * nN; G = G_; c = c_; }
    __host__ __device__ bool next(int i, Unit& u) const {
        const long L = (long)i * G + c; if (L >= nwg) return false;
        int wgid = (int)L; { const int q = nwg / NXCD, r = nwg % NXCD, xcd = wgid % NXCD, off = wgid / NXCD; wgid = (xcd < r ? xcd * (q + 1) : r * (q + 1) + (xcd - r) * q) + off; }
        const int nig = WGM * nN, gid = wgid / nig, fm = gid * WGM, gsz = (nM - fm) < WGM ? (nM - fm) : WGM;
        u.pm = fm + ((wgid % nig) % gsz); u.pn = (wgid % nig) / gsz; return true;
    }
    __device__ __forceinline__ void a_ready(const Unit&) const {}
    __device__ __forceinline__ void done(const Unit&) const {}
};
typedef __bf16 bf16v2_t __attribute__((ext_vector_type(2)));
typedef float f32v2_t __attribute__((ext_vector_type(2)));
__device__ __forceinline__ unsigned cvt_pk_bf16(float lo, float hi) { const f32v2_t v = {lo, hi}; return __builtin_bit_cast(unsigned, __builtin_convertvector(v, bf16v2_t)); }
__device__ __forceinline__ float bf_lo(unsigned w) { return __uint_as_float(w << 16); }
__device__ __forceinline__ float bf_hi(unsigned w) { return __uint_as_float(w & 0xffff0000u); }
__device__ __forceinline__ float sigm(float x) { return __builtin_amdgcn_rcpf(1.0f + __expf(-x)); }
enum { EP_STORE = 0, EP_GATE1 = 1, EP_GATE2 = 2, EP_RELU2 = 3, EP_FINAL = 4, EP_SPLIT = 5 };
template <int MODE> struct Epi {
    static constexpr bool PERM = true, AFTER_DRAIN = false;
    bf16_t* O; int ldc;
    const bf16_t* G; int ldg;
    float* F;
    __device__ __forceinline__ void operator()(const f32x4 (&acc)[2][2][4][2], const Unit& u, int wr, int wc, int fr, int fq) const {
        const int row0 = u.pm * BM + wr * 64 + fr; int colt = u.pn * BM; bf16_t* base = O; int ld = ldc;
        if (MODE == EP_SPLIT) {
            if (colt < 4096) { base = O + (size_t)(colt >> 10) * ((size_t)16384 * 1024); colt &= 1023; ld = 1024; }
            else { base = O + (size_t)4 * ((size_t)16384 * 1024); colt -= 4096; ld = 4096; }
        }
        const int col0 = colt + wc * 32 + 8 * fq;
#pragma unroll
        for (int ai = 0; ai < 2; ++ai)
#pragma unroll
            for (int m = 0; m < 4; ++m) { const size_t row = (size_t)(row0 + ai * HALF + m * 16);
#pragma unroll
                for (int bj = 0; bj < 2; ++bj) { const int col = col0 + bj * HALF; f32x4 v0 = acc[ai][bj][m][0], v1 = acc[ai][bj][m][1];
                    if (MODE == EP_FINAL) {
                        const u32x4 e = *(const u32x4*)(G + row * ldg + col); float* fp = F + row * ldc + col;
                        f32x4 h0 = *(const f32x4*)fp, h1 = *(const f32x4*)(fp + 4);
                        h0[0] += sigm(v0[0]) * bf_lo(e.x); h0[1] += sigm(v0[1]) * bf_hi(e.x); h0[2] += sigm(v0[2]) * bf_lo(e.y); h0[3] += sigm(v0[3]) * bf_hi(e.y);
                        h1[0] += sigm(v1[0]) * bf_lo(e.z); h1[1] += sigm(v1[1]) * bf_hi(e.z); h1[2] += sigm(v1[2]) * bf_lo(e.w); h1[3] += sigm(v1[3]) * bf_hi(e.w);
                        *(f32x4*)fp = h0; *(f32x4*)(fp + 4) = h1;
                    } else {
                        if (MODE == EP_GATE1 || MODE == EP_GATE2) {
                            const u32x4 g = *(const u32x4*)(G + row * ldg + col);
                            v0[0] *= sigm(bf_lo(g.x)); v0[1] *= sigm(bf_hi(g.x)); v0[2] *= sigm(bf_lo(g.y)); v0[3] *= sigm(bf_hi(g.y));
                            v1[0] *= sigm(bf_lo(g.z)); v1[1] *= sigm(bf_hi(g.z)); v1[2] *= sigm(bf_lo(g.w)); v1[3] *= sigm(bf_hi(g.w));
                        }
                        if (MODE == EP_GATE2) {
                            const u32x4 t = *(const u32x4*)(base + row * ld + col);
                            v0[0] += bf_lo(t.x); v0[1] += bf_hi(t.x); v0[2] += bf_lo(t.y); v0[3] += bf_hi(t.y);
                            v1[0] += bf_lo(t.z); v1[1] += bf_hi(t.z); v1[2] += bf_lo(t.w); v1[3] += bf_hi(t.w);
                        }
                        if (MODE == EP_RELU2) {
#pragma unroll
                            for (int q = 0; q < 4; ++q) { const float a = fmaxf(v0[q], 0.f), b = fmaxf(v1[q], 0.f); v0[q] = a * a; v1[q] = b * b; }
                        }
                        u32x4 w; w.x = cvt_pk_bf16(v0[0], v0[1]); w.y = cvt_pk_bf16(v0[2], v0[3]); w.z = cvt_pk_bf16(v1[0], v1[1]); w.w = cvt_pk_bf16(v1[2], v1[3]);
                        *(u32x4*)(base + row * ld + col) = w;
                    } } }
    }
};
template <class Epi, class Sched, bool ALIGN_EPI = false, bool SP2 = false>
__device__ __forceinline__ void gemm_phase(PG8_LAS unsigned char* lds, const Gemm g, const Sched& S, const Epi& E) {
    const int tid = threadIdx.x, wid = __builtin_amdgcn_readfirstlane(tid >> 6), lane = tid & 63, wr = wid >> 2, wc = wid & 3, fr = lane & 15, fq = lane >> 4;
    const int K = g.K, nt = K / BK;
    unsigned voffA[2], voffB[2];
#pragma unroll
    for (int i = 0; i < 2; ++i) { int R, C; stage_rc(tid * 16 + i * 8192, R, C); const int Rb = Epi::PERM ? ((R & ~31) + perm32(R & 31)) : R;
        voffA[i] = (unsigned)(R * K + C) * 2u; voffB[i] = (unsigned)(Rb * K + C) * 2u; }
    const size_t kstep = (size_t)(BK * 2);
    const size_t hstep = (size_t)HALF * K * 2;
    const size_t tstep = 2 * hstep;
    const unsigned ldsw = (unsigned)wid * 1024u;
    const int aoff = lds_byte(wr * 64 + fr, fq * 8), boff = lds_byte(wc * 32 + fr, fq * 8);
#define PG8_SA(b, h) (((b) * 2 + (h)) * HTB)
#define PG8_SB(b, h) ((4 + (b) * 2 + (h)) * HTB)
#define PG8_STAGE(bufoff, gbase, voff) do { _Pragma("unroll") for (int _i = 0; _i < 2; ++_i) \
        __builtin_amdgcn_global_load_lds((const unsigned*)((const char*)(gbase) + (voff)[_i]), (PG8_LAS unsigned*)(lds + (bufoff) + ldsw + _i * 8192), 16, 0, 0); } while (0)
#define PG8_LDA(dst, b, h) do { _Pragma("unroll") for (int m = 0; m < 4; ++m) _Pragma("unroll") for (int k = 0; k < 2; ++k) dst[m][k] = *(const PG8_LAS bf16x8*)(lds + PG8_SA(b, h) + aoff + m * 2048 + k * 1024); } while (0)
#define PG8_LDB(dst, b, h) do { _Pragma("unroll") for (int n = 0; n < 2; ++n) _Pragma("unroll") for (int k = 0; k < 2; ++k) dst[n][k] = *(const PG8_LAS bf16x8*)(lds + PG8_SB(b, h) + boff + n * 2048 + k * 1024); } while (0)
#define PG8_MMA(ai, bj, At, Bt) do { __builtin_amdgcn_s_setprio(1); _Pragma("unroll") for (int m = 0; m < 4; ++m) _Pragma("unroll") for (int n = 0; n < 2; ++n) _Pragma("unroll") for (int k = 0; k < 2; ++k) \
        acc[ai][bj][m][n] = __builtin_amdgcn_mfma_f32_16x16x32_bf16(Bt[n][k], At[m][k], acc[ai][bj][m][n], 0, 0, 0); __builtin_amdgcn_s_setprio(0); } while (0)
#define PG8_WAIT_V(n) asm volatile("s_waitcnt vmcnt(" #n ")" ::: "memory")
#define PG8_WAIT_L(n) asm volatile("s_waitcnt lgkmcnt(" #n ")" ::: "memory")
#define PG8_BAR __builtin_amdgcn_s_barrier()
#define PG8_SCHED __builtin_amdgcn_sched_barrier(0)
    Unit cur, nxt; int ui = 0;
    if (!S.next(0, cur)) return;
    f32x4 acc[2][2][4][2];
#pragma unroll
    for (int a = 0; a < 2; ++a)
#pragma unroll
        for (int b = 0; b < 2; ++b)
#pragma unroll
            for (int m = 0; m < 4; ++m)
#pragma unroll
                for (int n = 0; n < 2; ++n) acc[a][b][m][n] = (f32x4){0.f, 0.f, 0.f, 0.f};
    bf16x8 At[4][2], B0[2][2], B1[2][2];
    const char* cA = (const char*)g.A + (size_t)cur.pm * tstep; const char* cB = (const char*)g.Bt + (size_t)cur.pn * tstep;
    S.a_ready(cur);
    if constexpr (SP2) {
        PG8_STAGE(PG8_SB(0, 0), cB, voffB); PG8_STAGE(PG8_SB(0, 1), cB + hstep, voffB); PG8_STAGE(PG8_SA(0, 0), cA, voffA); PG8_STAGE(PG8_SA(0, 1), cA + hstep, voffA);
        if (wr == 1) PG8_BAR;
        PG8_WAIT_V(2); PG8_BAR;
        PG8_STAGE(PG8_SB(1, 0), cB + kstep, voffB); PG8_STAGE(PG8_SA(1, 0), cA + kstep, voffA); PG8_STAGE(PG8_SB(1, 1), cB + hstep + kstep, voffB);
        PG8_WAIT_V(6); PG8_BAR;
    } else {
        PG8_STAGE(PG8_SB(0, 0), cB, voffB); PG8_STAGE(PG8_SA(0, 0), cA, voffA); PG8_STAGE(PG8_SB(0, 1), cB + hstep, voffB); PG8_STAGE(PG8_SA(0, 1), cA + hstep, voffA);
        if (wr == 1) PG8_BAR;
        PG8_WAIT_V(4); PG8_BAR;
        PG8_STAGE(PG8_SB(1, 0), cB + kstep, voffB); PG8_STAGE(PG8_SA(1, 0), cA + kstep, voffA); PG8_STAGE(PG8_SB(1, 1), cB + hstep + kstep, voffB);
        PG8_WAIT_V(6); PG8_BAR;
    }
    for (;;) {
        const bool has_next = S.next(ui + 1, nxt);
        const char* nA = has_next ? (const char*)g.A + (size_t)nxt.pm * tstep : cA; const char* nB = has_next ? (const char*)g.Bt + (size_t)nxt.pn * tstep : cB;
        for (int t = 0; t < nt; t += 2) {
            const bool last = (t == nt - 2);
            const char* a1 = cA + (size_t)(t + 1) * kstep;
            const char* a2 = last ? nA : cA + (size_t)(t + 2) * kstep; const char* b2 = last ? nB : cB + (size_t)(t + 2) * kstep;
            const char* a3 = a2 + kstep; const char* b3 = b2 + kstep;
            if (last && has_next) S.a_ready(nxt);
            if constexpr (SP2) {
            PG8_LDB(B0, 0, 0); PG8_LDB(B1, 0, 1); PG8_SCHED; PG8_LDA(At, 0, 0); PG8_STAGE(PG8_SA(1, 1), a1 + hstep, voffA);
            PG8_WAIT_V(8); PG8_WAIT_L(0); PG8_BAR; PG8_MMA(0, 0, At, B0); PG8_MMA(0, 1, At, B1); PG8_BAR; PG8_SCHED;
            PG8_LDA(At, 0, 1); PG8_STAGE(PG8_SB(0, 0), b2, voffB); PG8_STAGE(PG8_SB(0, 1), b2 + hstep, voffB); PG8_STAGE(PG8_SA(0, 0), a2, voffA);
            PG8_WAIT_V(8); PG8_WAIT_L(0); PG8_BAR; PG8_MMA(1, 0, At, B0); PG8_MMA(1, 1, At, B1); PG8_BAR; PG8_SCHED;
            PG8_LDB(B0, 1, 0); PG8_LDB(B1, 1, 1); PG8_SCHED; PG8_LDA(At, 1, 0); PG8_STAGE(PG8_SA(0, 1), a2 + hstep, voffA);
            PG8_WAIT_V(8); PG8_WAIT_L(0); PG8_BAR; PG8_MMA(0, 0, At, B0); PG8_MMA(0, 1, At, B1); PG8_BAR; PG8_SCHED;
            PG8_LDA(At, 1, 1); PG8_STAGE(PG8_SB(1, 0), b3, voffB); PG8_STAGE(PG8_SB(1, 1), b3 + hstep, voffB); PG8_STAGE(PG8_SA(1, 0), a3, voffA);
            PG8_WAIT_V(8); PG8_WAIT_L(0); PG8_BAR; PG8_MMA(1, 0, At, B0); PG8_MMA(1, 1, At, B1); PG8_BAR; PG8_SCHED;
            } else {
            PG8_LDB(B0, 0, 0); PG8_SCHED; PG8_LDA(At, 0, 0); PG8_STAGE(PG8_SA(1, 1), a1 + hstep, voffA);
            PG8_WAIT_L(8); PG8_BAR; PG8_WAIT_L(0); PG8_MMA(0, 0, At, B0); PG8_BAR; PG8_SCHED;
            PG8_LDB(B1, 0, 1); PG8_STAGE(PG8_SB(0, 0), b2, voffB);
            PG8_BAR; PG8_WAIT_L(0); PG8_MMA(0, 1, At, B1); PG8_BAR;
            PG8_LDA(At, 0, 1); PG8_STAGE(PG8_SA(0, 0), a2, voffA);
            PG8_BAR; PG8_WAIT_L(0); PG8_MMA(1, 0, At, B0); PG8_BAR; PG8_SCHED;
            PG8_STAGE(PG8_SB(0, 1), b2 + hstep, voffB);
            PG8_WAIT_V(6); PG8_BAR; PG8_MMA(1, 1, At, B1); PG8_BAR;
            PG8_LDB(B0, 1, 0); PG8_SCHED; PG8_LDA(At, 1, 0); PG8_STAGE(PG8_SA(0, 1), a2 + hstep, voffA);
            PG8_WAIT_L(8); PG8_BAR; PG8_WAIT_L(0); PG8_MMA(0, 0, At, B0); PG8_BAR; PG8_SCHED;
            PG8_LDB(B1, 1, 1); PG8_STAGE(PG8_SB(1, 0), b3, voffB);
            PG8_BAR; PG8_WAIT_L(0); PG8_MMA(0, 1, At, B1); PG8_BAR;
            PG8_LDA(At, 1, 1); PG8_STAGE(PG8_SA(1, 0), a3, voffA);
            PG8_BAR; PG8_WAIT_L(0); PG8_MMA(1, 0, At, B0); PG8_BAR; PG8_SCHED;
            PG8_STAGE(PG8_SB(1, 1), b3 + hstep, voffB);
            PG8_WAIT_V(6); PG8_BAR; PG8_MMA(1, 1, At, B1); PG8_BAR;
            }
        }
        if constexpr (ALIGN_EPI) { if (wr == 0) PG8_BAR; }
        if constexpr (!Epi::AFTER_DRAIN) { E(acc, cur, wr, wc, fr, fq); S.done(cur); }
        if (!has_next) break;
#pragma unroll
        for (int a = 0; a < 2; ++a)
#pragma unroll
            for (int b = 0; b < 2; ++b)
#pragma unroll
                for (int m = 0; m < 4; ++m)
#pragma unroll
                    for (int n = 0; n < 2; ++n) acc[a][b][m][n] = (f32x4){0.f, 0.f, 0.f, 0.f};
        cur = nxt; cA = nA; cB = nB; ++ui;
        if constexpr (ALIGN_EPI) { if (wr == 1) PG8_BAR; }
    }
    PG8_WAIT_V(0);
    if constexpr (!ALIGN_EPI) { if (wr == 0) PG8_BAR; }
    PG8_BAR;
    if constexpr (Epi::AFTER_DRAIN) { E.fused(acc, cur, wr, wc, fr, fq, lds, wid, lane); S.done(cur); }
#undef PG8_SA
#undef PG8_SB
#undef PG8_STAGE
#undef PG8_LDA
#undef PG8_LDB
#undef PG8_MMA
#undef PG8_WAIT_V
#undef PG8_WAIT_L
#undef PG8_BAR
#undef PG8_SCHED
}
}

#define LAS __attribute__((address_space(3)))
typedef unsigned short bf16_t;
typedef short bf16x8 __attribute__((ext_vector_type(8)));
typedef short bf16x4 __attribute__((ext_vector_type(4)));
typedef float f32x4 __attribute__((ext_vector_type(4)));
typedef unsigned u32x4 __attribute__((ext_vector_type(4)));
typedef unsigned u32x2 __attribute__((ext_vector_type(2)));
constexpr int NB = 4, T = 4096, D = 2048, MT = NB * T, FF = 8192, PLE = 256, INW = 10256;
constexpr int ZW = 8192;
constexpr float EPS = 1e-6f;
constexpr int NWAVES = 8, NTHR = 512;
constexpr size_t MiB = (size_t)1 << 20;
constexpr size_t WS_CTL = 0, WS_PB = 1 * MiB, WS_WGLA = 9 * MiB, WS_WSB = 13 * MiB, WS_WOUT = 17 * MiB, WS_WPG = 25 * MiB, WS_WPP = 33 * MiB, WS_DEC = 34 * MiB;
constexpr int LDV = MT + 64;
constexpr size_t WS_V = 35 * MiB;
constexpr size_t WS_D = 100 * MiB;
constexpr size_t WS_XN1 = WS_D, WS_W1T = WS_D + 64 * MiB, WS_W2T = WS_D + 97 * MiB, WS_DST = WS_D, WS_MB = WS_D, WS_WUP = WS_D + 64 * MiB, WS_WDOWN = WS_D + 96 * MiB, WS_E = WS_D + 64 * MiB  , WS_XN2 = WS_V  ;
constexpr size_t WS_Z = 228 * MiB;
constexpr size_t WS_ZG = WS_Z, WS_GO = WS_Z + 32 * MiB, WS_SQ = WS_Z + 64 * MiB, WS_SK = WS_Z + 96 * MiB, WS_GAB = WS_Z + 128 * MiB, WS_GLR = WS_Z + 256 * MiB, WS_H = WS_Z;
constexpr size_t WS_END = 492 * MiB;
constexpr int LDS_BYTES = 147456, LDSCTL_OFF = 143360;
constexpr size_t WS_BAR = 16384, CTL_ZERO_BYTES = 65536;

__device__ __forceinline__ float bf2f(bf16_t h) { return __uint_as_float((unsigned)h << 16); }
__device__ __forceinline__ unsigned pk2(float lo, float hi) { return pg8::cvt_pk_bf16(lo, hi); }
__device__ __forceinline__ float wave_sum(float v) {
#pragma unroll
    for (int o = 1; o < 64; o <<= 1) v += __shfl_xor(v, o);
    return v;
}
__device__ __forceinline__ float logsig(float x) { return fminf(x, 0.f) - __logf(1.0f + __expf(-fabsf(x))); }
#define MFMA16(a, b, c) __builtin_amdgcn_mfma_f32_16x16x32_bf16((a), (b), (c), 0, 0, 0)
#define LDS_WAIT() asm volatile("s_waitcnt lgkmcnt(0)" ::: "memory")

struct Args { const float* in[18]; float* out; unsigned char* ws; int ph_lo, ph_hi, coop, pad; };

template <bool NTS> __device__ __forceinline__ void xpose_tile(const float* W, int ldw, int c0, int K, bf16_t* WT, int r0, int ncb, int item, LAS float* scr, int lane) {
    const int kb = item / ncb, nb = item % ncb, k0 = kb * 64, n0 = nb * 64;
    const float* src = W + (size_t)k0 * ldw + c0 + n0 + (lane & 15) * 4;
#pragma unroll 8
    for (int i = 0; i < 16; ++i) { const int kk = 4 * i + (lane >> 4); const f32x4 v = __builtin_nontemporal_load((const f32x4*)(src + (size_t)kk * ldw));
        LAS float* d = scr + kk * 65 + (lane & 15) * 4; d[0] = v[0]; d[1] = v[1]; d[2] = v[2]; d[3] = v[3]; }
    LDS_WAIT();
    const int c = lane & 7;
#pragma unroll
    for (int j = 0; j < 8; ++j) { const int n = (lane >> 3) + 8 * j; const LAS float* s = scr + (8 * c) * 65 + n;
        u32x4 o; o.x = pk2(s[0], s[65]); o.y = pk2(s[2 * 65], s[3 * 65]); o.z = pk2(s[4 * 65], s[5 * 65]); o.w = pk2(s[6 * 65], s[7 * 65]);
        if (NTS) __builtin_nontemporal_store(o, (u32x4*)(WT + (size_t)(r0 + n0 + n) * K + k0 + 8 * c)); else *(u32x4*)(WT + (size_t)(r0 + n0 + n) * K + k0 + 8 * c) = o; }
    LDS_WAIT();
}
struct XJob { const float* W; int ldw, c0, K, ncols; bf16_t* WT; int r0; };
template <bool NTS = false> __device__ __forceinline__ void xpose_job(const XJob& j, int& base, int gw, int NGW, LAS float* scr, int lane) {
    const int ncb = j.ncols / 64, n = (j.K / 64) * ncb;
    int it = gw - (base % NGW); if (it < 0) it += NGW;
    for (; it < n; it += NGW) xpose_tile<NTS>(j.W, j.ldw, j.c0, j.K, j.WT, j.r0, ncb, it, scr, lane);
    base += n;
}
__device__ __forceinline__ void rms_row_store(const f32x4 (&v)[8], float ss, const float* gain, bf16_t* orow, int lane) {
    const float r = rsqrtf(wave_sum(ss) * (1.f / D) + EPS);
#pragma unroll
    for (int j = 0; j < 8; ++j) { const f32x4 g = *(const f32x4*)(gain + 256 * j + 4 * lane);
        u32x2 o; o.x = pk2(v[j][0] * r * g[0], v[j][1] * r * g[1]); o.y = pk2(v[j][2] * r * g[2], v[j][3] * r * g[3]);
        *(u32x2*)(orow + 256 * j + 4 * lane) = o; }
}
__device__ __forceinline__ void p0_rows(const float* x, const float* gain, bf16_t* XN, const float* p, bf16_t* PB, int gw, int NGW, int lane) {
    for (int m0 = gw; m0 < MT; m0 += 2 * NGW) {
        const int m1 = (m0 + NGW < MT) ? m0 + NGW : m0;
        const float* xa = x + (size_t)m0 * D + 4 * lane; const float* xb = x + (size_t)m1 * D + 4 * lane; f32x4 va[8], vb[8]; float sa = 0.f, sb = 0.f;
#pragma unroll
        for (int j = 0; j < 8; ++j) va[j] = __builtin_nontemporal_load((const f32x4*)(xa + 256 * j));
#pragma unroll
        for (int j = 0; j < 8; ++j) vb[j] = __builtin_nontemporal_load((const f32x4*)(xb + 256 * j));
        const f32x4 pa = *(const f32x4*)(p + (size_t)m0 * PLE + 4 * lane), pb = *(const f32x4*)(p + (size_t)m1 * PLE + 4 * lane);
#pragma unroll
        for (int j = 0; j < 8; ++j) sa += (va[j][0] * va[j][0] + va[j][1] * va[j][1]) + (va[j][2] * va[j][2] + va[j][3] * va[j][3]);
        rms_row_store(va, sa, gain, XN + (size_t)m0 * D, lane);
#pragma unroll
        for (int j = 0; j < 8; ++j) sb += (vb[j][0] * vb[j][0] + vb[j][1] * vb[j][1]) + (vb[j][2] * vb[j][2] + vb[j][3] * vb[j][3]);
        rms_row_store(vb, sb, gain, XN + (size_t)m1 * D, lane);
        u32x2 o; o.x = pk2(pa[0], pa[1]); o.y = pk2(pa[2], pa[3]); *(u32x2*)(PB + (size_t)m0 * PLE + 4 * lane) = o;
        o.x = pk2(pb[0], pb[1]); o.y = pk2(pb[2], pb[3]); *(u32x2*)(PB + (size_t)m1 * PLE + 4 * lane) = o;
    }
}
__device__ __forceinline__ void glr_gemm(LAS unsigned char* lds, const bf16_t* XN, const float* w_in, float* GLRF, int bid, int G, int tid) {
    const int lane = tid & 63, wave = __builtin_amdgcn_readfirstlane(tid >> 6), fr = lane & 15, fq = lane >> 4;
    LAS unsigned char* WT = lds;
    LAS float* RED = (LAS float*)(lds + 65792);
    if (bid >= MT / 64) return;
#pragma unroll
    for (int i = 0; i < 16; ++i) { const int idx = tid + 512 * i, k = idx >> 2, q4 = idx & 3; const f32x4 v = *(const f32x4*)(w_in + (size_t)k * INW + 2048 + 4 * q4);
#pragma unroll
        for (int q = 0; q < 4; ++q) *(LAS bf16_t*)(WT + (4 * q4 + q) * 4112 + k * 2) = (bf16_t)(pk2(v[q], 0.f) & 0xffffu); }
    __syncthreads();
    for (int rg = bid; rg < MT / 64; rg += G) {
        const int st = wave & 3, kh = wave >> 2;
        const bf16_t* arow = XN + (size_t)(64 * rg + 16 * st + fr) * D + kh * 1024 + fq * 8;
        f32x4 acc = (f32x4){0.f, 0.f, 0.f, 0.f};
#pragma unroll 16
        for (int ks = 0; ks < 32; ++ks) { const bf16x8 a = *(const bf16x8*)(arow + ks * 32);
            const bf16x8 b = *(const LAS bf16x8*)(WT + fr * 4112 + (kh * 1024 + ks * 32 + fq * 8) * 2); acc = MFMA16(a, b, acc); }
        if (kh == 1) *(LAS f32x4*)(RED + (st * 64 + lane) * 4) = acc;
        __syncthreads();
        if (kh == 0) { const f32x4 o = acc + *(const LAS f32x4*)(RED + (st * 64 + lane) * 4);
#pragma unroll
            for (int j = 0; j < 4; ++j) GLRF[(size_t)(64 * rg + 16 * st + 4 * fq + j) * 16 + fr] = o[j]; }
        __syncthreads();
    }
}
__device__ __forceinline__ void resid_row_body(const u32x2 (&sw)[8], f32x4 (&v)[8], float* ho, const float* g_post, const float* g_next, bf16_t* xo, int lane) {
    f32x4 s[8]; float ss = 0.f;
#pragma unroll
    for (int j = 0; j < 8; ++j) { s[j][0] = pg8::bf_lo(sw[j].x); s[j][1] = pg8::bf_hi(sw[j].x); s[j][2] = pg8::bf_lo(sw[j].y); s[j][3] = pg8::bf_hi(sw[j].y);
        ss += (s[j][0] * s[j][0] + s[j][1] * s[j][1]) + (s[j][2] * s[j][2] + s[j][3] * s[j][3]); }
    const float r = rsqrtf(wave_sum(ss) * (1.f / D) + EPS); float s2 = 0.f;
#pragma unroll
    for (int j = 0; j < 8; ++j) { const f32x4 g = *(const f32x4*)(g_post + 256 * j + 4 * lane);
#pragma unroll
        for (int q = 0; q < 4; ++q) { v[j][q] += s[j][q] * r * g[q]; s2 += v[j][q] * v[j][q]; }
        *(f32x4*)(ho + 256 * j) = v[j]; }
    rms_row_store(v, s2, g_next, xo, lane);
}
__device__ __forceinline__ void resid_rows(const bf16_t* S, const float* hin, float* hout, const float* g_post, const float* g_next, bf16_t* XNo, int gw, int NGW, int lane) {
    for (int m0 = gw; m0 < MT; m0 += 2 * NGW) {
        const bool two = (m0 + NGW < MT); const int m1 = two ? m0 + NGW : m0;
        u32x2 swa[8], swb[8]; f32x4 va[8], vb[8];
#pragma unroll
        for (int j = 0; j < 8; ++j) { swa[j] = *(const u32x2*)(S + (size_t)m0 * D + 4 * lane + 256 * j); va[j] = *(const f32x4*)(hin + (size_t)m0 * D + 4 * lane + 256 * j); }
#pragma unroll
        for (int j = 0; j < 8; ++j) { swb[j] = *(const u32x2*)(S + (size_t)m1 * D + 4 * lane + 256 * j); vb[j] = *(const f32x4*)(hin + (size_t)m1 * D + 4 * lane + 256 * j); }
        resid_row_body(swa, va, hout + (size_t)m0 * D + 4 * lane, g_post, g_next, XNo + (size_t)m0 * D, lane);
        if (two) resid_row_body(swb, vb, hout + (size_t)m1 * D + 4 * lane, g_post, g_next, XNo + (size_t)m1 * D, lane);
    }
}

__device__ __forceinline__ void unpack8(const u32x2 (&w)[8], f32x4 (&s)[8], float& ss) {
    ss = 0.f;
#pragma unroll
    for (int j = 0; j < 8; ++j) { s[j][0] = pg8::bf_lo(w[j].x); s[j][1] = pg8::bf_hi(w[j].x); s[j][2] = pg8::bf_lo(w[j].y); s[j][3] = pg8::bf_hi(w[j].y);
        ss += (s[j][0] * s[j][0] + s[j][1] * s[j][1]) + (s[j][2] * s[j][2] + s[j][3] * s[j][3]); }
}
__device__ __forceinline__ void add_normed(f32x4 (&v)[8], const f32x4 (&s)[8], float ss, const float* gain, int lane, float& s2) {
    const float r = rsqrtf(wave_sum(ss) * (1.f / D) + EPS); s2 = 0.f;
#pragma unroll
    for (int j = 0; j < 8; ++j) { const f32x4 g = *(const f32x4*)(gain + 256 * j + 4 * lane);
#pragma unroll
        for (int q = 0; q < 4; ++q) { v[j][q] += s[j][q] * r * g[q]; s2 += v[j][q] * v[j][q]; } }
}
__device__ __forceinline__ void r1_rows(const bf16_t* Mb, const float* x, const float* g1, const float* gn, bf16_t* XNo, int gw, int NGW, int lane) {
    for (int m0 = gw; m0 < MT; m0 += 2 * NGW) {
        const bool two = (m0 + NGW < MT); const int m1 = two ? m0 + NGW : m0;
        u32x2 wa[8], wb[8]; f32x4 va[8], vb[8];
#pragma unroll
        for (int j = 0; j < 8; ++j) { wa[j] = *(const u32x2*)(Mb + (size_t)m0 * D + 4 * lane + 256 * j); va[j] = __builtin_nontemporal_load((const f32x4*)(x + (size_t)m0 * D + 4 * lane + 256 * j)); }
#pragma unroll
        for (int j = 0; j < 8; ++j) { wb[j] = *(const u32x2*)(Mb + (size_t)m1 * D + 4 * lane + 256 * j); vb[j] = __builtin_nontemporal_load((const f32x4*)(x + (size_t)m1 * D + 4 * lane + 256 * j)); }
        { f32x4 s[8]; float ss, s2; unpack8(wa, s, ss); add_normed(va, s, ss, g1, lane, s2); rms_row_store(va, s2, gn, XNo + (size_t)m0 * D, lane); }
        if (two) { f32x4 s[8]; float ss, s2; unpack8(wb, s, ss); add_normed(vb, s, ss, g1, lane, s2); rms_row_store(vb, s2, gn, XNo + (size_t)m1 * D, lane); }
    }
}
__device__ __forceinline__ void r2_row(const u32x2 (&wm)[8], const u32x2 (&wf)[8], f32x4 (&v)[8], const float* g1, const float* g2, const float* g3, float* ho, bf16_t* xo, int lane) {
    f32x4 s[8]; float ss, s2;
    unpack8(wm, s, ss); add_normed(v, s, ss, g1, lane, s2);
    unpack8(wf, s, ss); add_normed(v, s, ss, g2, lane, s2);
#pragma unroll
    for (int j = 0; j < 8; ++j) *(f32x4*)(ho + 256 * j) = v[j];
    rms_row_store(v, s2, g3, xo, lane);
}
__device__ __forceinline__ void r2_rows(const bf16_t* Mb, const bf16_t* Fb, const float* x, float* hout, const float* g1, const float* g2, const float* g3, bf16_t* XNo, int gw, int NGW, int lane) {
    for (int m0 = gw; m0 < MT; m0 += NGW) {
        u32x2 ma[8], fa[8]; f32x4 va[8];
#pragma unroll
        for (int j = 0; j < 8; ++j) { ma[j] = *(const u32x2*)(Mb + (size_t)m0 * D + 4 * lane + 256 * j); fa[j] = *(const u32x2*)(Fb + (size_t)m0 * D + 4 * lane + 256 * j); va[j] = *(const f32x4*)(x + (size_t)m0 * D + 4 * lane + 256 * j); }
        r2_row(ma, fa, va, g1, g2, g3, hout + (size_t)m0 * D + 4 * lane, XNo + (size_t)m0 * D, lane);
    }
}

constexpr int ATT_BUF = 64 * 272 + 128 * 144;
constexpr float ATT_RTHR = -150.1f;
template <bool MASK> __device__ __forceinline__ void attn_tile(const LAS unsigned char* Ks, const LAS unsigned char* Vs, const bf16x8 (&qf)[4], f32x4 (&oacc)[8], float& R, int s0, int tq, int fr, int fq) {
    f32x4 sacc[4];
#pragma unroll
    for (int i = 0; i < 4; ++i) { sacc[i] = (f32x4){0.f, 0.f, 0.f, 0.f};
#pragma unroll
        for (int ks = 0; ks < 4; ++ks) { const bf16x8 a = *(const LAS bf16x8*)(Ks + (16 * i + fr) * 272 + ks * 64 + fq * 16); sacc[i] = MFMA16(a, qf[ks], sacc[i]); } }
    const float sc2 = 0.08838834764831845f * 1.4426950408889634f;
    float lb[4][4], l1[4][4], tot[4], above[4];
#pragma unroll
    for (int i = 0; i < 4; ++i) {
#pragma unroll
        for (int j = 0; j < 4; ++j) { const float z = sacc[i][j] * sc2; const float lbv = fminf(z, 0.f) - __builtin_amdgcn_logf(1.0f + __builtin_amdgcn_exp2f(-fabsf(z)));
            lb[i][j] = lbv; l1[i][j] = (!MASK || (s0 + 16 * i + 4 * fq + j) < tq) ? (lbv - z) : 0.f; }
        const float g = (l1[i][0] + l1[i][1]) + (l1[i][2] + l1[i][3]);
        const float g1 = __shfl_xor(g, 16), g2 = __shfl_xor(g, 32), g3 = __shfl_xor(g, 48);
        above[i] = (((fq ^ 1) > fq) ? g1 : 0.f) + (((fq ^ 2) > fq) ? g2 : 0.f) + (((fq ^ 3) > fq) ? g3 : 0.f);
        tot[i] = (g + g1) + (g2 + g3);
    }
    float run = R; float A[4][4];
#pragma unroll
    for (int i = 3; i >= 0; --i) { const float s3 = run + above[i], s2 = s3 + l1[i][3], s1 = s2 + l1[i][2], sz = s1 + l1[i][1];
        const int kb_ = s0 + 16 * i + 4 * fq;
        A[i][3] = (!MASK || kb_ + 3 < tq) ? __builtin_amdgcn_exp2f(lb[i][3] + s3) : 0.f; A[i][2] = (!MASK || kb_ + 2 < tq) ? __builtin_amdgcn_exp2f(lb[i][2] + s2) : 0.f;
        A[i][1] = (!MASK || kb_ + 1 < tq) ? __builtin_amdgcn_exp2f(lb[i][1] + s1) : 0.f; A[i][0] = (!MASK || kb_ < tq) ? __builtin_amdgcn_exp2f(lb[i][0] + sz) : 0.f;
        run += tot[i]; }
    R = run;
#pragma unroll
    for (int s = 0; s < 2; ++s) {
        u32x4 pb; pb.x = pk2(A[2 * s][0], A[2 * s][1]); pb.y = pk2(A[2 * s][2], A[2 * s][3]); pb.z = pk2(A[2 * s + 1][0], A[2 * s + 1][1]); pb.w = pk2(A[2 * s + 1][2], A[2 * s + 1][3]);
        const bf16x8 bfrag = __builtin_bit_cast(bf16x8, pb);
#pragma unroll
        for (int di = 0; di < 8; ++di) { const LAS unsigned char* vp = Vs + (16 * di + fr) * 144 + (32 * s + 4 * fq) * 2;
            const u32x2 lo = *(const LAS u32x2*)vp, hi = *(const LAS u32x2*)(vp + 32);
            u32x4 av; av.x = lo.x; av.y = lo.y; av.z = hi.x; av.w = hi.y;
            oacc[di] = MFMA16(__builtin_bit_cast(bf16x8, av), bfrag, oacc[di]); }
    }
}
__device__ __forceinline__ void attn_unit(LAS unsigned char* lds, bf16_t* SQ, bf16_t* OUTB, const bf16_t* SK, const bf16_t* VT, int b, int h, int qb, int tid) {
    const int lane = tid & 63, w = __builtin_amdgcn_readfirstlane(tid >> 6), fr = lane & 15, fq = lane >> 4;
    LAS unsigned char* Ks = lds;
    LAS unsigned char* Vs = lds + 64 * 272;
    const int tw0 = qb * 128 + w * 16;
    bf16_t* qrow = SQ + (size_t)(b * T + tw0 + fr) * 1024 + h * 128;
    bf16x8 qf[4];
#pragma unroll
    for (int ks = 0; ks < 4; ++ks) qf[ks] = *(const bf16x8*)(qrow + ks * 32 + fq * 8);
    f32x4 oacc[8];
#pragma unroll
    for (int i = 0; i < 8; ++i) oacc[i] = (f32x4){0.f, 0.f, 0.f, 0.f};
    float R = 0.f;
    const int nkt = 2 * qb + 2;
    const bf16_t* kbase = SK + (size_t)(b * T) * 1024 + h * 128;
    const bf16_t* vbase = VT + (size_t)(1024 + h * 128) * LDV + (size_t)b * T;
    u32x4 ak[2], av[2], bk[2], bv[2];
#define ATT_PREFETCH(RK, RV, kt) do { _Pragma("unroll") for (int i_ = 0; i_ < 2; ++i_) { const int idx_ = tid + 512 * i_; \
        RK[i_] = *(const u32x4*)(kbase + (size_t)((kt) * 64 + (idx_ >> 4)) * 1024 + (idx_ & 15) * 8); \
        RV[i_] = *(const u32x4*)(vbase + (size_t)(idx_ >> 3) * LDV + (kt) * 64 + (idx_ & 7) * 8); } } while (0)
#define ATT_WRITE(RK, RV, pp) do { _Pragma("unroll") for (int i_ = 0; i_ < 2; ++i_) { const int idx_ = tid + 512 * i_; \
        *(LAS u32x4*)(Ks + (pp) * ATT_BUF + (idx_ >> 4) * 272 + (idx_ & 15) * 16) = RK[i_]; \
        *(LAS u32x4*)(Vs + (pp) * ATT_BUF + (idx_ >> 3) * 144 + (idx_ & 7) * 16) = RV[i_]; } } while (0)
#define ATT_STEP(T, P, RK, RV) { const int t_ = (T); const int s0 = t_ * 64; \
        const bool wdone = __builtin_amdgcn_ballot_w64(R < ATT_RTHR) == ~0ull; \
        if (s0 <= tw0 && !wdone) { \
            if (s0 + 63 < tw0) attn_tile<false>(Ks + (P) * ATT_BUF, Vs + (P) * ATT_BUF, qf, oacc, R, s0, tw0 + fr, fr, fq); \
            else attn_tile<true>(Ks + (P) * ATT_BUF, Vs + (P) * ATT_BUF, qf, oacc, R, s0, tw0 + fr, fr, fq); } \
        if (t_ > 0) { ATT_WRITE(RK, RV, (P) ^ 1); if (t_ > 2) ATT_PREFETCH(RK, RV, t_ - 3); } \
        const bool live = __builtin_amdgcn_ballot_w64(R < ATT_RTHR) != ~0ull; const int vn = (vw == 2) ? 0 : vw + 1; \
        if (live && lane == 0) vote[vw] = 1u; \
        if (tid == 0) vote[vn] = 0u; \
        __syncthreads(); \
        if (vote[vw] == 0u || t_ == 0) break; \
        vw = vn; }
    volatile LAS unsigned* vote = (volatile LAS unsigned*)(lds + 2 * ATT_BUF);
    ATT_PREFETCH(ak, av, nkt - 1);
    ATT_WRITE(ak, av, 0);
    ATT_PREFETCH(ak, av, nkt - 2);
    if (nkt > 2) ATT_PREFETCH(bk, bv, nkt - 3);
    if (tid < 3) vote[tid] = 0u;
    __syncthreads();
    int vw = 0;
    for (int kt = nkt - 1; ; kt -= 2) {
        ATT_STEP(kt, 0, ak, av)
        ATT_STEP(kt - 1, 1, bk, bv)
    }
#undef ATT_STEP
#undef ATT_WRITE
#undef ATT_PREFETCH
#pragma unroll
    for (int di = 0; di < 8; ++di) { u32x2 o; o.x = pk2(oacc[di][0], oacc[di][1]); o.y = pk2(oacc[di][2], oacc[di][3]);
        *(u32x2*)(OUTB + (size_t)(b * T + tw0 + fr) * 1024 + h * 128 + 16 * di + 4 * fq) = o; }
    __syncthreads();
}

__device__ __forceinline__ void gla_cumdecay(LAS unsigned char* scr, const float* GLR, const float* Wg, const float* bg, int r0, int h, int tid, float (&bcum)[16], float& blast) {
    LAS float* sG = (LAS float*)scr;
    LAS float* sTot = (LAS float*)(scr + 4096);
    const int d = tid & 127, tg = tid >> 7;
#pragma unroll
    for (int i = 0; i < 2; ++i) { const int e = tid + 512 * i; sG[e] = GLR[(size_t)r0 * 16 + e]; }
    float wg[16];
#pragma unroll
    for (int r = 0; r < 16; ++r) wg[r] = Wg[r * 512 + h * 128 + d];
    const float bias = bg[h * 128 + d];
    __syncthreads();
    float run = 0.f;
#pragma unroll
    for (int i = 0; i < 16; ++i) { const LAS float* g = sG + (tg * 16 + i) * 16; float x = bias;
#pragma unroll
        for (int r = 0; r < 16; ++r) x += g[r] * wg[r];
        run += logsig(x) * (1.0f / 16.0f); bcum[i] = run; }
    sTot[tg * 128 + d] = run;
    __syncthreads();
    float pre = 0.f, all = 0.f;
#pragma unroll
    for (int g = 0; g < 4; ++g) { const float v = sTot[g * 128 + d]; all += v; if (g < tg) pre += v; }
#pragma unroll
    for (int i = 0; i < 16; ++i) bcum[i] += pre;
    blast = all;
}
__device__ __forceinline__ void gla_pass_a(LAS unsigned char* lds, const bf16_t* ZG, const float* GLR, const bf16_t* VT, const float* Wg, const float* bg, bf16_t* DST, float* DEC, int item, int tid) {
    const int bh = item >> 6, n = item & 63, b = bh >> 2, h = bh & 3, r0 = b * T + n * 64;
    const int lane = tid & 63, w = __builtin_amdgcn_readfirstlane(tid >> 6), fr = lane & 15, fq = lane >> 4, d = tid & 127, tg = tid >> 7;
    LAS unsigned char* KsT = lds;
    LAS unsigned char* scr = lds + 128 * 144;
    float bcum[16], blast;
    bf16_t kraw[16];
#pragma unroll
    for (int i = 0; i < 16; ++i) kraw[i] = ZG[(size_t)(r0 + tg * 16 + i) * 1024 + 512 + h * 128 + d];
    gla_cumdecay(scr, GLR, Wg, bg, r0, h, tid, bcum, blast);
    unsigned pk[8];
#pragma unroll
    for (int i = 0; i < 16; i += 2) { const float k0 = bf2f(kraw[i]), k1 = bf2f(kraw[i + 1]);
        pk[i >> 1] = pk2(k0 * __expf(blast - bcum[i]), k1 * __expf(blast - bcum[i + 1])); }
    *(LAS u32x4*)(KsT + d * 144 + tg * 32) = (u32x4){pk[0], pk[1], pk[2], pk[3]};
    *(LAS u32x4*)(KsT + d * 144 + tg * 32 + 16) = (u32x4){pk[4], pk[5], pk[6], pk[7]};
    if (tg == 0) DEC[item * 128 + d] = __expf(blast);
    __syncthreads();
    const bf16_t* vt = VT + (size_t)(h * 256) * LDV + r0;
    bf16_t* dst = DST + (size_t)item * 32768;
#pragma unroll
    for (int ee = 0; ee < 2; ++ee) { const int ei = 2 * w + ee;
        bf16x8 vb[2];
#pragma unroll
        for (int ks = 0; ks < 2; ++ks) vb[ks] = *(const bf16x8*)(vt + (size_t)(16 * ei + fr) * LDV + ks * 32 + fq * 8);
#pragma unroll
        for (int di = 0; di < 8; ++di) { f32x4 acc = (f32x4){0.f, 0.f, 0.f, 0.f};
#pragma unroll
            for (int ks = 0; ks < 2; ++ks) { const bf16x8 a = *(const LAS bf16x8*)(KsT + (16 * di + fr) * 144 + ks * 64 + fq * 16); acc = MFMA16(a, vb[ks], acc); }
            u32x2 o; o.x = pk2(acc[0], acc[1]); o.y = pk2(acc[2], acc[3]);
            *(u32x2*)(dst + (size_t)(16 * ei + fr) * 128 + 16 * di + 4 * fq) = o; }
    }
    __syncthreads();
}
__device__ __forceinline__ void gla_pass_b(bf16_t* DST, const float* DEC, int gtid, int nthreads) {
    for (int idx = gtid; idx < 16 * 256 * 32; idx += nthreads) {
        const int d4 = idx & 31, e = (idx >> 5) & 255, bh = idx >> 13;
        bf16_t* p = DST + (size_t)(bh * 64) * 32768 + e * 128 + d4 * 4; const float* dc = DEC + (size_t)(bh * 64) * 128 + d4 * 4;
        f32x4 S = (f32x4){0.f, 0.f, 0.f, 0.f};
#pragma unroll 9
        for (int n = 0; n < 63; ++n) { const u32x2 w = *(const u32x2*)(p + (size_t)n * 32768); const f32x4 dd = *(const f32x4*)(dc + n * 128);
            const f32x4 v = (f32x4){pg8::bf_lo(w.x), pg8::bf_hi(w.x), pg8::bf_lo(w.y), pg8::bf_hi(w.y)};
            S = dd * S + v; u32x2 o; o.x = pk2(S[0], S[1]); o.y = pk2(S[2], S[3]); *(u32x2*)(p + (size_t)n * 32768) = o; }
    }
}
__device__ __forceinline__ void gla_pass_c(LAS unsigned char* lds, const bf16_t* ZG, const float* GLR, const bf16_t* VT, const float* Wg, const float* bg, const bf16_t* DST, const float* gn, bf16_t* GO, int item, int tid) {
    const int bh = item >> 6, n = item & 63, b = bh >> 2, h = bh & 3, r0 = b * T + n * 64;
    const int lane = tid & 63, w = __builtin_amdgcn_readfirstlane(tid >> 6), fr = lane & 15, fq = lane >> 4, d = tid & 127, tg = tid >> 7;
    LAS unsigned char* Qd = lds;
    LAS unsigned char* Ki = lds + 17408;
    LAS unsigned char* P = lds + 34816;
    LAS float* sSS = (LAS float*)(lds + 44032);
    LAS unsigned char* scr = lds + 45056;
    float bcum[16], blast;
    bf16_t qraw[16], kraw[16];
#pragma unroll
    for (int i = 0; i < 16; ++i) { const bf16_t* zr = ZG + (size_t)(r0 + tg * 16 + i) * 1024 + h * 128 + d; qraw[i] = zr[0]; kraw[i] = zr[512]; }
    gla_cumdecay(scr, GLR, Wg, bg, r0, h, tid, bcum, blast);
#pragma unroll
    for (int i = 0; i < 16; ++i) { const int t = tg * 16 + i;
        const float q = bf2f(qraw[i]), k = bf2f(kraw[i]);
        *(LAS bf16_t*)(Qd + t * 272 + d * 2) = (bf16_t)(pk2(q * 0.08838834764831845f * __expf(bcum[i]), 0.f) & 0xffffu);
        *(LAS bf16_t*)(Ki + t * 272 + d * 2) = (bf16_t)(pk2(k * __expf(-bcum[i]), 0.f) & 0xffffu); }
    __syncthreads();
    const int ti = w >> 1;
    {
#pragma unroll
        for (int ss = 0; ss < 2; ++ss) { const int si = 2 * (w & 1) + ss; f32x4 acc = (f32x4){0.f, 0.f, 0.f, 0.f};
            if (si <= ti) {
#pragma unroll
                for (int ks = 0; ks < 4; ++ks) { const bf16x8 a = *(const LAS bf16x8*)(Ki + (16 * si + fr) * 272 + ks * 64 + fq * 16), bq = *(const LAS bf16x8*)(Qd + (16 * ti + fr) * 272 + ks * 64 + fq * 16);
                    acc = MFMA16(a, bq, acc); } }
            const int tt = 16 * ti + fr, sb = 16 * si + 4 * fq;
            u32x2 o; o.x = pk2(sb <= tt ? acc[0] : 0.f, sb + 1 <= tt ? acc[1] : 0.f); o.y = pk2(sb + 2 <= tt ? acc[2] : 0.f, sb + 3 <= tt ? acc[3] : 0.f);
            *(LAS u32x2*)(P + tt * 144 + sb * 2) = o; }
    }
    __syncthreads();
    const int eh = w & 1;
    bf16x8 pf[2], qf[4];
#pragma unroll
    for (int ks = 0; ks < 2; ++ks) pf[ks] = *(const LAS bf16x8*)(P + (16 * ti + fr) * 144 + ks * 64 + fq * 16);
#pragma unroll
    for (int ks = 0; ks < 4; ++ks) qf[ks] = *(const LAS bf16x8*)(Qd + (16 * ti + fr) * 272 + ks * 64 + fq * 16);
    const bf16_t* vt = VT + (size_t)(h * 256) * LDV + r0;
    const bf16_t* sp = DST + (size_t)(item - 1) * 32768;
    f32x4 acc[8]; float ssq = 0.f;
#pragma unroll
    for (int e8 = 0; e8 < 8; ++e8) { const int ei = 8 * eh + e8; acc[e8] = (f32x4){0.f, 0.f, 0.f, 0.f};
#pragma unroll
        for (int ks = 0; ks < 2; ++ks) { const bf16x8 a = *(const bf16x8*)(vt + (size_t)(16 * ei + fr) * LDV + ks * 32 + fq * 8); acc[e8] = MFMA16(a, pf[ks], acc[e8]); }
        if (n > 0) {
#pragma unroll
            for (int ks = 0; ks < 4; ++ks) { const bf16x8 av = *(const bf16x8*)(sp + (size_t)(16 * ei + fr) * 128 + ks * 32 + fq * 8);
                acc[e8] = MFMA16(av, qf[ks], acc[e8]); } }
        ssq += (acc[e8][0] * acc[e8][0] + acc[e8][1] * acc[e8][1]) + (acc[e8][2] * acc[e8][2] + acc[e8][3] * acc[e8][3]);
    }
    ssq += __shfl_xor(ssq, 16); ssq += __shfl_xor(ssq, 32);
    if (fq == 0) sSS[eh * 64 + 16 * ti + fr] = ssq;
    __syncthreads();
    const float rn = rsqrtf((sSS[16 * ti + fr] + sSS[64 + 16 * ti + fr]) * (1.0f / 256.0f) + EPS);
    bf16_t* gor = GO + (size_t)(r0 + 16 * ti + fr) * 1024 + h * 256;
#pragma unroll
    for (int e8 = 0; e8 < 8; ++e8) { const int e0 = 16 * (8 * eh + e8) + 4 * fq; const f32x4 g = *(const f32x4*)(gn + e0);
        const u32x2 gw = *(const u32x2*)(gor + e0); const float x0 = pg8::bf_lo(gw.x), x1 = pg8::bf_hi(gw.x), x2 = pg8::bf_lo(gw.y), x3 = pg8::bf_hi(gw.y);
        u32x2 o; o.x = pk2(acc[e8][0] * rn * g[0] * x0 * pg8::sigm(x0), acc[e8][1] * rn * g[1] * x1 * pg8::sigm(x1));
        o.y = pk2(acc[e8][2] * rn * g[2] * x2 * pg8::sigm(x2), acc[e8][3] * rn * g[3] * x3 * pg8::sigm(x3));
        *(u32x2*)(gor + e0) = o; }
    __syncthreads();
}
#define XB_TMO      128
#define XB_XCNT(j)  (256  + 64 * (j))
#define XB_XSUB(j)  (1280 + 64 * (j))
#define XB_XGEN(j)  (2304 + 64 * (j))
#define XB_TOP      3328
#define XB_TOPGEN   3392
#define XCD_BAR_WORDS 3456
#define XB_SPIN_CAP (1u << 18)

__device__ __forceinline__ unsigned xb_ld(unsigned* p)              { return __hip_atomic_load(p, __ATOMIC_RELAXED, __HIP_MEMORY_SCOPE_AGENT); }
__device__ __forceinline__ unsigned xb_add(unsigned* p, unsigned v) { return __hip_atomic_fetch_add(p, v, __ATOMIC_RELAXED, __HIP_MEMORY_SCOPE_AGENT); }
__device__ __forceinline__ unsigned xb_xcc_id() { return (unsigned)__builtin_amdgcn_s_getreg((3 << 11) | 20) & 0xFu; }
#define XB_SPIN(cond, bar) do { unsigned _sp = 0; while (cond) { __builtin_amdgcn_s_sleep(1); \
    if ((++_sp & 255u) == 0u) { if (xb_ld(&(bar)[XB_TMO])) break; if (_sp > XB_SPIN_CAP) { atomicAdd(&(bar)[XB_TMO], 1u); break; } } } } while (0)

struct XcdBarrier {
    unsigned* bar; unsigned x;
    volatile LAS unsigned* st;
};

__device__ __forceinline__ XcdBarrier xcd_barrier_post(unsigned* bar, volatile LAS unsigned* st) {
    XcdBarrier b; b.bar = bar; b.x = xb_xcc_id(); b.st = st;
    if (threadIdx.x == 0) (void)xb_add(&bar[XB_XCNT(b.x)], 1u);
    return b;
}
__device__ __forceinline__ void xcd_barrier_complete(unsigned* bar, unsigned x, unsigned& nloc, unsigned& nx) {
    const unsigned G = gridDim.x * gridDim.y * gridDim.z;
    unsigned sum, cnt, mine, sp = 0u;
    for (;;) {
        sum = 0u; cnt = 0u; mine = 0u;
#pragma unroll
        for (unsigned j = 0; j < 16; ++j) { const unsigned c = xb_ld(&bar[XB_XCNT(j)]); sum += c; cnt += (c > 0u) ? 1u : 0u; mine = (j == x) ? c : mine; }
        if (sum == G) break;
        __builtin_amdgcn_s_sleep(1);
        if ((++sp & 255u) == 0u) { if (xb_ld(&bar[XB_TMO])) break; if (sp > XB_SPIN_CAP) { atomicAdd(&bar[XB_TMO], 1u); break; } }
    }
    nloc = mine > 0u ? mine : 1u; nx = cnt > 0u ? cnt : 1u;
}

__device__ __forceinline__ void xcd_barrier(const XcdBarrier& b) {
    asm volatile("s_waitcnt vmcnt(0)" ::: "memory");
    __syncthreads();
    if (threadIdx.x == 0) {
        unsigned* bar = b.bar;
        __builtin_amdgcn_s_waitcnt(0);
        unsigned nloc = b.st[0], nx = b.st[1];
        if (nloc == 0u) { xcd_barrier_complete(bar, b.x, nloc, nx); b.st[0] = nloc; b.st[1] = nx; }
        const unsigned old = xb_add(&bar[XB_XSUB(b.x)], 1u);
        const unsigned gen = old / nloc;
        if (old + 1u == (gen + 1u) * nloc) {
            __builtin_amdgcn_fence(__ATOMIC_RELEASE, "agent");
            asm volatile("s_waitcnt vmcnt(0)" ::: "memory");
            const unsigned og = xb_add(&bar[XB_TOP], 1u);
            const unsigned tg = og / nx;
            if (og + 1u == (tg + 1u) * nx) {
#pragma unroll
                for (unsigned j = 0; j < 16; ++j) (void)xb_add(&bar[XB_XGEN(j)], 1u);
            } else XB_SPIN(xb_ld(&bar[XB_XGEN(b.x)]) == gen, bar);
            __builtin_amdgcn_fence(__ATOMIC_ACQUIRE, "agent");
            asm volatile("s_waitcnt vmcnt(0)" ::: "memory");
        } else {
            XB_SPIN(xb_ld(&bar[XB_XGEN(b.x)]) == gen, bar);
            __builtin_amdgcn_fence(__ATOMIC_ACQUIRE, "agent");
            asm volatile("s_waitcnt vmcnt(0)" ::: "memory");
        }
    }
    __syncthreads();
}

#ifndef MK_SPLIT
#define MK_SPLIT 0
#endif
constexpr int N_PHASES = 12;
__global__ void __launch_bounds__(NTHR, 2) fwd_kernel(Args args) {
    extern __shared__ __attribute__((aligned(16))) unsigned char lds_raw[];
    LAS unsigned char* lds = (LAS unsigned char*)lds_raw;
    const int tid = threadIdx.x, lane = tid & 63, wave = __builtin_amdgcn_readfirstlane(tid >> 6);
    const int G = gridDim.x, bid = blockIdx.x;
    const int gw = bid * NWAVES + wave, NGW = G * NWAVES;
    unsigned char* ws = args.ws;
    const float* x = args.in[0]; const float* p = args.in[1]; const float* g_mix_pre = args.in[2]; const float* g_mix_post = args.in[3];
    const float* w_in = args.in[4]; const float* w_gate_up = args.in[5]; const float* b_gate = args.in[6]; const float* gla_norm = args.in[7];
    const float* w_bgla = args.in[8]; const float* w_bsb = args.in[9]; const float* w_out = args.in[10]; const float* g_mlp_pre = args.in[11];
    const float* g_mlp_post = args.in[12]; const float* w_up = args.in[13]; const float* w_down = args.in[14]; const float* g_ple = args.in[15];
    const float* w_pg = args.in[16]; const float* w_pp = args.in[17]; float* out = args.out;
    bf16_t* PB = (bf16_t*)(ws + WS_PB); bf16_t* WGLA = (bf16_t*)(ws + WS_WGLA); bf16_t* WSB = (bf16_t*)(ws + WS_WSB); bf16_t* WOUT = (bf16_t*)(ws + WS_WOUT);
    bf16_t* WPG = (bf16_t*)(ws + WS_WPG); bf16_t* WPP = (bf16_t*)(ws + WS_WPP); float* DEC = (float*)(ws + WS_DEC);
    bf16_t* VT = (bf16_t*)(ws + WS_V); bf16_t* Y = (bf16_t*)(ws + WS_V); bf16_t* FB = (bf16_t*)(ws + WS_V);
    bf16_t* XN1 = (bf16_t*)(ws + WS_XN1); bf16_t* W1T = (bf16_t*)(ws + WS_W1T); bf16_t* W2T = (bf16_t*)(ws + WS_W2T); bf16_t* DST = (bf16_t*)(ws + WS_DST);
    bf16_t* MB = (bf16_t*)(ws + WS_MB); bf16_t* WUP = (bf16_t*)(ws + WS_WUP); bf16_t* WDOWN = (bf16_t*)(ws + WS_WDOWN); bf16_t* EB = (bf16_t*)(ws + WS_E); bf16_t* XN2 = (bf16_t*)(ws + WS_XN2);
    bf16_t* ZG = (bf16_t*)(ws + WS_ZG); bf16_t* GO = (bf16_t*)(ws + WS_GO); bf16_t* SQ = (bf16_t*)(ws + WS_SQ); bf16_t* SK = (bf16_t*)(ws + WS_SK);
    bf16_t* GAB = (bf16_t*)(ws + WS_GAB); float* GLR = (float*)(ws + WS_GLR); bf16_t* HB = (bf16_t*)(ws + WS_H);
    const int lo = args.ph_lo, hi = args.ph_hi;
#define IN(k) (lo <= (k) && (k) < hi)
#define SEAM(k) do { if (IN(k) && IN((k) + 1)) { xcd_barrier(bar); } } while (0)
    if (args.coop == 2) cg::this_grid().sync();
    if (tid < 32) ((LAS unsigned*)(lds + LDSCTL_OFF))[tid] = 0u;
    __syncthreads();
    const XcdBarrier bar = xcd_barrier_post((unsigned*)(ws + WS_BAR), (volatile LAS unsigned*)(lds + LDSCTL_OFF));
    LAS float* xscr = (LAS float*)(lds + wave * 16640);

    if (IN(0)) {
        int base = 0;
        const XJob jobs[14] = {
            {w_in, INW, 0, D, 512, W1T, 0}, {w_in, INW, 512, D, 512, W1T, 512}, {w_in, INW, 2064, D, 1024, W1T, 1024}, {w_in, INW, 3088, D, 1024, W1T, 2048},
            {w_in, INW, 4112, D, 1024, W1T, 3072}, {w_in, INW, 6160, D, 2048, W1T, 4096}, {w_in, INW, 8208, D, 2048, W1T, 6144},
            {w_in, INW, 1024, D, 1024, W2T, 0}, {w_in, INW, 5136, D, 1024, W2T, 1024},
            {w_bgla, D, 0, 1024, D, WGLA, 0}, {w_bsb, D, 0, 1024, D, WSB, 0}, {w_out, D, 0, D, D, WOUT, 0}, {w_pg, D, 0, D, D, WPG, 0}, {w_pp, D, 0, PLE, D, WPP, 0} };
#pragma unroll
        for (int j = 0; j < 14; ++j) xpose_job(jobs[j], base, gw, NGW, xscr, lane);
        p0_rows(x, g_mix_pre, XN1, p, PB, gw, NGW, lane);
    }
    SEAM(0);
    if (IN(1)) {
        { pg8::Gemm g{XN1, W1T, MT, ZW, D}; pg8::StaticOrder S; S.init(MT, ZW, G, bid); pg8::Epi<pg8::EP_SPLIT> E{ZG, 0, nullptr, 0, nullptr};
          pg8::gemm_phase<pg8::Epi<pg8::EP_SPLIT>, pg8::StaticOrder, true, true>(lds, g, S, E); }
        { pg8::Gemm g{W2T, XN1, 2048, MT, D}; pg8::StaticOrder S; S.init(2048, MT, G, bid); pg8::Epi<pg8::EP_STORE> E{VT, LDV, nullptr, 0, nullptr};
          pg8::gemm_phase<pg8::Epi<pg8::EP_STORE>, pg8::StaticOrder, true, true>(lds, g, S, E); }
        glr_gemm(lds, XN1, w_in, GLR, bid, G, tid);
    }
    SEAM(1);
    if (IN(2)) {
        const int role = (bid >> 3) & 3;
#pragma unroll 1
        for (int s = 0; s < 4; ++s) {
            if (s == role) { __syncthreads(); int base = 0; const XJob j0{w_up, FF, 0, D, FF, WUP, 0}, j1{w_down, D, 0, FF, D, WDOWN, 0};
                xpose_job<true>(j0, base, gw, NGW, xscr, lane); xpose_job<true>(j1, base, gw, NGW, xscr, lane); __syncthreads(); }
            if (s < 2) {
                for (int i = 2 * s; (s == 0 ? i < 2 : true) && i * G + bid < 1024; ++i) { int j = i * G + bid; if ((i & 1) && (i + 1) * G <= 1024) j = (i + 1) * G - 1 - bid;
                    const int qb = 31 - (j >> 5), bh = j & 31; attn_unit(lds, SQ, SQ, SK, VT, bh >> 3, bh & 7, qb, tid); }
            } else if (s == 2) {
                for (int it = bid; it < 1024; it += G) gla_pass_a(lds, ZG, GLR, VT, w_gate_up, b_gate, DST, DEC, it, tid);
            }
        }
    }
    SEAM(2);
    if (IN(3)) gla_pass_b(DST, DEC, bid * NTHR + tid, G * NTHR);
    SEAM(3);
    if (IN(4)) { for (int it = bid; it < 1024; it += G) gla_pass_c(lds, ZG, GLR, VT, w_gate_up, b_gate, DST, gla_norm, GO, it, tid); }
    SEAM(4);
    if (IN(5)) {
        { pg8::Gemm g{GO, WGLA, MT, D, 1024}; pg8::StaticOrder S; S.init(MT, D, G, bid); pg8::Epi<pg8::EP_GATE1> E{Y, D, GAB, 4096, nullptr};
          pg8::gemm_phase<pg8::Epi<pg8::EP_GATE1>, pg8::StaticOrder, false, true>(lds, g, S, E); }
        { pg8::Gemm g{SQ, WSB, MT, D, 1024}; pg8::StaticOrder S; S.init(MT, D, G, bid); pg8::Epi<pg8::EP_GATE2> E{Y, D, GAB + 2048, 4096, nullptr};
          pg8::gemm_phase<pg8::Epi<pg8::EP_GATE2>, pg8::StaticOrder, false, true>(lds, g, S, E); }
    }
    SEAM(5);
    if (IN(6)) { pg8::Gemm g{Y, WOUT, MT, D, D}; pg8::StaticOrder S; S.init(MT, D, G, bid); pg8::Epi<pg8::EP_STORE> E{MB, D, nullptr, 0, nullptr};
        pg8::gemm_phase<pg8::Epi<pg8::EP_STORE>, pg8::StaticOrder, true, true>(lds, g, S, E); }
    SEAM(6);
    if (IN(7)) {
        r1_rows(MB, x, g_mix_post, g_mlp_pre, XN2, gw, NGW, lane);
    }
    SEAM(7);
    if (IN(8)) { pg8::Gemm g{XN2, WUP, MT, FF, D}; pg8::StaticOrder S; S.init(MT, FF, G, bid); pg8::Epi<pg8::EP_RELU2> E{HB, FF, nullptr, 0, nullptr};
        pg8::gemm_phase<pg8::Epi<pg8::EP_RELU2>, pg8::StaticOrder, true, true>(lds, g, S, E); }
    SEAM(8);
    if (IN(9)) { pg8::Gemm g{HB, WDOWN, MT, D, FF}; pg8::StaticOrder S; S.init(MT, D, G, bid); pg8::Epi<pg8::EP_STORE> E{FB, D, nullptr, 0, nullptr};
        pg8::gemm_phase<pg8::Epi<pg8::EP_STORE>, pg8::StaticOrder, true, true>(lds, g, S, E); }
    SEAM(9);
    if (IN(10)) {
        if ((bid >> 3) & 1) r2_rows(MB, FB, x, out, g_mix_post, g_mlp_post, g_ple, FB, gw, NGW, lane);
        __syncthreads();
        { pg8::Gemm g{PB, WPP, MT, D, PLE}; pg8::StaticOrder S; S.init(MT, D, G, bid); pg8::Epi<pg8::EP_STORE> E{EB, D, nullptr, 0, nullptr};
          pg8::gemm_phase<pg8::Epi<pg8::EP_STORE>, pg8::StaticOrder, true, true>(lds, g, S, E); }
        __syncthreads();
        if (!((bid >> 3) & 1)) r2_rows(MB, FB, x, out, g_mix_post, g_mlp_post, g_ple, FB, gw, NGW, lane);
    }
    SEAM(10);
    if (IN(11)) {
        { pg8::Gemm g{FB, WPG, MT, D, D}; pg8::StaticOrder S; S.init(MT, D, G, bid); pg8::Epi<pg8::EP_FINAL> E{nullptr, D, EB, D, out};
          pg8::gemm_phase<pg8::Epi<pg8::EP_FINAL>, pg8::StaticOrder, false, true>(lds, g, S, E); }
    }
#undef IN
#undef SEAM
}

extern "C" void kernel_launch(void* const* d_in, const int* in_sizes, int n_in, void* d_out, int out_size, void* d_ws, size_t ws_size, hipStream_t stream) {
    static int grid = 0;
    if (grid == 0) {
        if (n_in != 18 || in_sizes[0] != MT * D || out_size != MT * D || ws_size < WS_END) { fprintf(stderr, "kernel_launch: unexpected shapes (n_in %d, in0 %d, out %d, ws %zu)\n", n_in, n_in > 0 ? in_sizes[0] : -1, out_size, ws_size); grid = -1; return; }
        int dev = 0, cus = 0, per_cu = 0;
        if (hipGetDevice(&dev) != hipSuccess || hipDeviceGetAttribute(&cus, hipDeviceAttributeMultiprocessorCount, dev) != hipSuccess) { grid = -1; return; }
        if (hipFuncSetAttribute((const void*)fwd_kernel, hipFuncAttributeMaxDynamicSharedMemorySize, LDS_BYTES) != hipSuccess) { fprintf(stderr, "kernel_launch: hipFuncSetAttribute failed\n"); grid = -1; return; }
        if (hipOccupancyMaxActiveBlocksPerMultiprocessor(&per_cu, (const void*)fwd_kernel, NTHR, LDS_BYTES) != hipSuccess || per_cu < 1) { fprintf(stderr, "kernel_launch: occupancy query gave %d\n", per_cu); per_cu = 1; }
        (void)hipGetLastError();
        grid = cus;
    }
    if (grid < 0) return;
    if (hipMemsetAsync((char*)d_ws + WS_CTL, 0, CTL_ZERO_BYTES, stream) != hipSuccess) { fprintf(stderr, "kernel_launch: memset failed\n"); return; }
    Args a{};
    for (int i = 0; i < 18; ++i) a.in[i] = (const float*)d_in[i];
    a.out = (float*)d_out; a.ws = (unsigned char*)d_ws;
#if MK_SPLIT
    for (int ph = 0; ph < N_PHASES; ++ph) { a.ph_lo = ph; a.ph_hi = ph + 1; a.coop = 0;
        hipLaunchKernelGGL(fwd_kernel, dim3(grid), dim3(NTHR), LDS_BYTES, stream, a); }
#else
    a.ph_lo = 0; a.ph_hi = N_PHASES; a.coop = 1;
    void* kargs[] = {&a};
    const hipError_t e = hipLaunchCooperativeKernel((const void*)fwd_kernel, dim3(grid), dim3(NTHR), kargs, LDS_BYTES, stream);
    if (e != hipSuccess) fprintf(stderr, "kernel_launch: cooperative launch failed: %s (grid %d)\n", hipGetErrorString(e), grid);
#endif
}
```

```cpp
#include <hip/hip_runtime.h>
#include <hip/hip_cooperative_groups.h>
#include <cstdio>
#include <cstdint>
namespace cg = cooperative_groups;
namespace pg8 {
#define PG8_LAS __attribute__((address_space(3)))
typedef unsigned short bf16_t;
typedef short bf16x8 __attribute__((ext_vector_type(8)));
typedef float f32x4 __attribute__((ext_vector_type(4)));
typedef unsigned u32x4 __attribute__((ext_vector_type(4)));
constexpr int BM = 256, BK = 64, HALF = 128, HTB = HALF * BK * 2  , STAGE_BYTES = 8 * HTB, NXCD = 8, WGM = 4;

__host__ __device__ __forceinline__ int lds_byte(int r, int c) { const int st = (r >> 4) * 2 + (c >> 5), rr = r & 15, cc = c & 31, ob = rr * 64 + cc * 2; return st * 1024 + (ob ^ (((ob >> 9) & 1) << 5)); }
__host__ __device__ __forceinline__ void stage_rc(int b, int& R, int& C) { const int st = b / 1024, sb = b % 1024, swz = sb ^ (((sb >> 9) & 1) << 5); R = (st >> 1) * 16 + swz / 64; C = (st & 1) * 32 + (swz % 64) / 2; }
__host__ __device__ __forceinline__ int perm32(int rho) { const int n = rho >> 4, i = rho & 15; return 8 * (i >> 2) + 4 * n + (i & 3); }

struct Unit { int pm, pn; };
struct Gemm { const bf16_t* A; const bf16_t* Bt; int M, N, K; };

struct StaticOrder {
    int nM, nN, nwg, G, c;
    __host__ __device__ void init(int M, int N, int G_, int c_) { nM = M / BM; nN = N / BM; nwg = nM * nN; G = G_; c = c_; }
    __host__ __device__ bool next(int i, Unit& u) const {
        const long L = (long)i * G + c; if (L >= nwg) return false;
        int wgid = (int)L; { const int q = nwg / NXCD, r = nwg % NXCD, xcd = wgid % NXCD, off = wgid / NXCD; wgid = (xcd < r ? xcd * (q + 1) : r * (q + 1) + (xcd - r) * q) + off; }
        const int nig = WGM * nN, gid = wgid / nig, fm = gid * WGM, gsz = (nM - fm) < WGM ? (nM - fm) : WGM;
        u.pm = fm + ((wgid % nig) % gsz); u.pn = (wgid % nig) / gsz; return true;
    }
    __device__ __forceinline__ void a_ready(const Unit&) const {}
    __device__ __forceinline__ void done(const Unit&) const {}
};
typedef __bf16 bf16v2_t __attribute__((ext_vector_type(2)));
typedef float f32v2_t __attribute__((ext_vector_type(2)));
__device__ __forceinline__ unsigned cvt_pk_bf16(float lo, float hi) { const f32v2_t v = {lo, hi}; return __builtin_bit_cast(unsigned, __builtin_convertvector(v, bf16v2_t)); }
__device__ __forceinline__ float bf_lo(unsigned w) { return __uint_as_float(w << 16); }
__device__ __forceinline__ float bf_hi(unsigned w) { return __uint_as_float(w & 0xffff0000u); }
__device__ __forceinline__ float sigm(float x) { return __builtin_amdgcn_rcpf(1.0f + __expf(-x)); }
enum { EP_STORE = 0, EP_GATE1 = 1, EP_GATE2 = 2, EP_RELU2 = 3, EP_FINAL = 4, EP_SPLIT = 5 };
template <int MODE> struct Epi {
    static constexpr bool PERM = true, AFTER_DRAIN = false;
    bf16_t* O; int ldc;
    const bf16_t* G; int ldg;
    float* F;
    __device__ __forceinline__ void operator()(const f32x4 (&acc)[2][2][4][2], const Unit& u, int wr, int wc, int fr, int fq) const {
        const int row0 = u.pm * BM + wr * 64 + fr; int colt = u.pn * BM; bf16_t* base = O; int ld = ldc;
        if (MODE == EP_SPLIT) {
            if (colt < 4096) { base = O + (size_t)(colt >> 10) * ((size_t)16384 * 1024); colt &= 1023; ld = 1024; }
            else { base = O + (size_t)4 * ((size_t)16384 * 1024); colt -= 4096; ld = 4096; }
        }
        const int col0 = colt + wc * 32 + 8 * fq;
#pragma unroll
        for (int ai = 0; ai < 2; ++ai)
#pragma unroll
            for (int m = 0; m < 4; ++m) { const size_t row = (size_t)(row0 + ai * HALF + m * 16);
#pragma unroll
                for (int bj = 0; bj < 2; ++bj) { const int col = col0 + bj * HALF; f32x4 v0 = acc[ai][bj][m][0], v1 = acc[ai][bj][m][1];
                    if (MODE == EP_FINAL) {
                        const u32x4 e = *(const u32x4*)(G + row * ldg + col); float* fp = F + row * ldc + col;
                        f32x4 h0 = *(const f32x4*)fp, h1 = *(const f32x4*)(fp + 4);
                        h0[0] += sigm(v0[0]) * bf_lo(e.x); h0[1] += sigm(v0[1]) * bf_hi(e.x); h0[2] += sigm(v0[2]) * bf_lo(e.y); h0[3] += sigm(v0[3]) * bf_hi(e.y);
                        h1[0] += sigm(v1[0]) * bf_lo(e.z); h1[1] += sigm(v1[1]) * bf_hi(e.z); h1[2] += sigm(v1[2]) * bf_lo(e.w); h1[3] += sigm(v1[3]) * bf_hi(e.w);
                        *(f32x4*)fp = h0; *(f32x4*)(fp + 4) = h1;
                    } else {
                        if (MODE == EP_GATE1 || MODE == EP_GATE2) {
                            const u32x4 g = *(const u32x4*)(G + row * ldg + col);
                            v0[0] *= sigm(bf_lo(g.x)); v0[1] *= sigm(bf_hi(g.x)); v0[2] *= sigm(bf_lo(g.y)); v0[3] *= sigm(bf_hi(g.y));
                            v1[0] *= sigm(bf_lo(g.z)); v1[1] *= sigm(bf_hi(g.z)); v1[2] *= sigm(bf_lo(g.w)); v1[3] *= sigm(bf_hi(g.w));
                        }
                        if (MODE == EP_GATE2) {
                            const u32x4 t = *(const u32x4*)(base + row * ld + col);
                            v0[0] += bf_lo(t.x); v0[1] += bf_hi(t.x); v0[2] += bf_lo(t.y); v0[3] += bf_hi(t.y);
                            v1[0] += bf_lo(t.z); v1[1] += bf_hi(t.z); v1[2] += bf_lo(t.w); v1[3] += bf_hi(t.w);
                        }
                        if (MODE == EP_RELU2) {
#pragma unroll
                            for (int q = 0; q < 4; ++q) { const float a = fmaxf(v0[q], 0.f), b = fmaxf(v1[q], 0.f); v0[q] = a * a; v1[q] = b * b; }
                        }
                        u32x4 w; w.x = cvt_pk_bf16(v0[0], v0[1]); w.y = cvt_pk_bf16(v0[2], v0[3]); w.z = cvt_pk_bf16(v1[0], v1[1]); w.w = cvt_pk_bf16(v1[2], v1[3]);
                        *(u32x4*)(base + row * ld + col) = w;
                    } } }
    }
};
template <class Epi, class Sched, bool ALIGN_EPI = false, bool SP2 = false>
__device__ __forceinline__ void gemm_phase(PG8_LAS unsigned char* lds, const Gemm g, const Sched& S, const Epi& E) {
    const int tid = threadIdx.x, wid = __builtin_amdgcn_readfirstlane(tid >> 6), lane = tid & 63, wr = wid >> 2, wc = wid & 3, fr = lane & 15, fq = lane >> 4;
    const int K = g.K, nt = K / BK;
    unsigned voffA[2], voffB[2];
#pragma unroll
    for (int i = 0; i < 2; ++i) { int R, C; stage_rc(tid * 16 + i * 8192, R, C); const int Rb = Epi::PERM ? ((R & ~31) + perm32(R & 31)) : R;
        voffA[i] = (unsigned)(R * K + C) * 2u; voffB[i] = (unsigned)(Rb * K + C) * 2u; }
    const size_t kstep = (size_t)(BK * 2);
    const size_t hstep = (size_t)HALF * K * 2;
    const size_t tstep = 2 * hstep;
    const unsigned ldsw = (unsigned)wid * 1024u;
    const int aoff = lds_byte(wr * 64 + fr, fq * 8), boff = lds_byte(wc * 32 + fr, fq * 8);
#define PG8_SA(b, h) (((b) * 2 + (h)) * HTB)
#define PG8_SB(b, h) ((4 + (b) * 2 + (h)) * HTB)
#define PG8_STAGE(bufoff, gbase, voff) do { _Pragma("unroll") for (int _i = 0; _i < 2; ++_i) \
        __builtin_amdgcn_global_load_lds((const unsigned*)((const char*)(gbase) + (voff)[_i]), (PG8_LAS unsigned*)(lds + (bufoff) + ldsw + _i * 8192), 16, 0, 0); } while (0)
#define PG8_LDA(dst, b, h) do { _Pragma("unroll") for (int m = 0; m < 4; ++m) _Pragma("unroll") for (int k = 0; k < 2; ++k) dst[m][k] = *(const PG8_LAS bf16x8*)(lds + PG8_SA(b, h) + aoff + m * 2048 + k * 1024); } while (0)
#define PG8_LDB(dst, b, h) do { _Pragma("unroll") for (int n = 0; n < 2; ++n) _Pragma("unroll") for (int k = 0; k < 2; ++k) dst[n][k] = *(const PG8_LAS bf16x8*)(lds + PG8_SB(b, h) + boff + n * 2048 + k * 1024); } while (0)
#define PG8_MMA(ai, bj, At, Bt) do { __builtin_amdgcn_s_setprio(1); _Pragma("unroll") for (int m = 0; m < 4; ++m) _Pragma("unroll") for (int n = 0; n < 2; ++n) _Pragma("unroll") for (int k = 0; k < 2; ++k) \
        acc[ai][bj][m][n] = __builtin_amdgcn_mfma_f32_16x16x32_bf16(Bt[n][k], At[m][k], acc[ai][bj][m][n], 0, 0, 0); __builtin_amdgcn_s_setprio(0); } while (0)
#define PG8_WAIT_V(n) asm volatile("s_waitcnt vmcnt(" #n ")" ::: "memory")
#define PG8_WAIT_L(n) asm volatile("s_waitcnt lgkmcnt(" #n ")" ::: "memory")
#define PG8_BAR __builtin_amdgcn_s_barrier()
#define PG8_SCHED __builtin_amdgcn_sched_barrier(0)
    Unit cur, nxt; int ui = 0;
    if (!S.next(0, cur)) return;
    f32x4 acc[2][2][4][2];
#pragma unroll
    for (int a = 0; a < 2; ++a)
#pragma unroll
        for (int b = 0; b < 2; ++b)
#pragma unroll
            for (int m = 0; m < 4; ++m)
#pragma unroll
                for (int n = 0; n < 2; ++n) acc[a][b][m][n] = (f32x4){0.f, 0.f, 0.f, 0.f};
    bf16x8 At[4][2], B0[2][2], B1[2][2];
    const char* cA = (const char*)g.A + (size_t)cur.pm * tstep; const char* cB = (const char*)g.Bt + (size_t)cur.pn * tstep;
    S.a_ready(cur);
    if constexpr (SP2) {
        PG8_STAGE(PG8_SB(0, 0), cB, voffB); PG8_STAGE(PG8_SB(0, 1), cB + hstep, voffB); PG8_STAGE(PG8_SA(0, 0), cA, voffA); PG8_STAGE(PG8_SA(0, 1), cA + hstep, voffA);
        if (wr == 1) PG8_BAR;
        PG8_WAIT_V(2); PG8_BAR;
        PG8_STAGE(PG8_SB(1, 0), cB + kstep, voffB); PG8_STAGE(PG8_SA(1, 0), cA + kstep, voffA); PG8_STAGE(PG8_SB(1, 1), cB + hstep + kstep, voffB);
        PG8_WAIT_V(6); PG8_BAR;
    } else {
        PG8_STAGE(PG8_SB(0, 0), cB, voffB); PG8_STAGE(PG8_SA(0, 0), cA, voffA); PG8_STAGE(PG8_SB(0, 1), cB + hstep, voffB); PG8_STAGE(PG8_SA(0, 1), cA + hstep, voffA);
        if (wr == 1) PG8_BAR;
        PG8_WAIT_V(4); PG8_BAR;
        PG8_STAGE(PG8_SB(1, 0), cB + kstep, voffB); PG8_STAGE(PG8_SA(1, 0), cA + kstep, voffA); PG8_STAGE(PG8_SB(1, 1), cB + hstep + kstep, voffB);
        PG8_WAIT_V(6); PG8_BAR;
    }
    for (;;) {
        const bool has_next = S.next(ui + 1, nxt);
        const char* nA = has_next ? (const char*)g.A + (size_t)nxt.pm * tstep : cA; const char* nB = has_next ? (const char*)g.Bt + (size_t)nxt.pn * tstep : cB;
        for (int t = 0; t < nt; t += 2) {
            const bool last = (t == nt - 2);
            const char* a1 = cA + (size_t)(t + 1) * kstep;
            const char* a2 = last ? nA : cA + (size_t)(t + 2) * kstep; const char* b2 = last ? nB : cB + (size_t)(t + 2) * kstep;
            const char* a3 = a2 + kstep; const char* b3 = b2 + kstep;
            if (last && has_next) S.a_ready(nxt);
            if constexpr (SP2) {
            PG8_LDB(B0, 0, 0); PG8_LDB(B1, 0, 1); PG8_SCHED; PG8_LDA(At, 0, 0); PG8_STAGE(PG8_SA(1, 1), a1 + hstep, voffA);
            PG8_WAIT_V(8); PG8_WAIT_L(0); PG8_BAR; PG8_MMA(0, 0, At, B0); PG8_MMA(0, 1, At, B1); PG8_BAR; PG8_SCHED;
            PG8_LDA(At, 0, 1); PG8_STAGE(PG8_SB(0, 0), b2, voffB); PG8_STAGE(PG8_SB(0, 1), b2 + hstep, voffB); PG8_STAGE(PG8_SA(0, 0), a2, voffA);
            PG8_WAIT_V(8); PG8_WAIT_L(0); PG8_BAR; PG8_MMA(1, 0, At, B0); PG8_MMA(1, 1, At, B1); PG8_BAR; PG8_SCHED;
            PG8_LDB(B0, 1, 0); PG8_LDB(B1, 1, 1); PG8_SCHED; PG8_LDA(At, 1, 0); PG8_STAGE(PG8_SA(0, 1), a2 + hstep, voffA);
            PG8_WAIT_V(8); PG8_WAIT_L(0); PG8_BAR; PG8_MMA(0, 0, At, B0); PG8_MMA(0, 1, At, B1); PG8_BAR; PG8_SCHED;
            PG8_LDA(At, 1, 1); PG8_STAGE(PG8_SB(1, 0), b3, voffB); PG8_STAGE(PG8_SB(1, 1), b3 + hstep, voffB); PG8_STAGE(PG8_SA(1, 0), a3, voffA);
            PG8_WAIT_V(8); PG8_WAIT_L(0); PG8_BAR; PG8_MMA(1, 0, At, B0); PG8_MMA(1, 1, At, B1); PG8_BAR; PG8_SCHED;
            } else {
            PG8_LDB(B0, 0, 0); PG8_SCHED; PG8_LDA(At, 0, 0); PG8_STAGE(PG8_SA(1, 1), a1 + hstep, voffA);
            PG8_WAIT_L(8); PG8_BAR; PG8_WAIT_L(0); PG8_MMA(0, 0, At, B0); PG8_BAR; PG8_SCHED;
            PG8_LDB(B1, 0, 1); PG8_STAGE(PG8_SB(0, 0), b2, voffB);
            PG8_BAR; PG8_WAIT_L(0); PG8_MMA(0, 1, At, B1); PG8_BAR;
            PG8_LDA(At, 0, 1); PG8_STAGE(PG8_SA(0, 0), a2, voffA);
            PG8_BAR; PG8_WAIT_L(0); PG8_MMA(1, 0, At, B0); PG8_BAR; PG8_SCHED;
            PG8_STAGE(PG8_SB(0, 1), b2 + hstep, voffB);
            PG8_WAIT_V(6); PG8_BAR; PG8_MMA(1, 1, At, B1); PG8_BAR;
            PG8_LDB(B0, 1, 0); PG8_SCHED; PG8_LDA(At, 1, 0); PG8_STAGE(PG8_SA(0, 1), a2 + hstep, voffA);
            PG8_WAIT_L(8); PG8_BAR; PG8_WAIT_L(0); PG8_MMA(0, 0, At, B0); PG8_BAR; PG8_SCHED;
            PG8_LDB(B1, 1, 1); PG8_STAGE(PG8_SB(1, 0), b3, voffB);
            PG8_BAR; PG8_WAIT_L(0); PG8_MMA(0, 1, At, B1); PG8_BAR;
            PG8_LDA(At, 1, 1); PG8_STAGE(PG8_SA(1, 0), a3, voffA);
            PG8_BAR; PG8_WAIT_L(0); PG8_MMA(1, 0, At, B0); PG8_BAR; PG8_SCHED;
            PG8_STAGE(PG8_SB(1, 1), b3 + hstep, voffB);
            PG8_WAIT_V(6); PG8_BAR; PG8_MMA(1, 1, At, B1); PG8_BAR;
            }
        }
        if constexpr (ALIGN_EPI) { if (wr == 0) PG8_BAR; }
        if constexpr (!Epi::AFTER_DRAIN) { E(acc, cur, wr, wc, fr, fq); S.done(cur); }
        if (!has_next) break;
#pragma unroll
        for (int a = 0; a < 2; ++a)
#pragma unroll
            for (int b = 0; b < 2; ++b)
#pragma unroll
                for (int m = 0; m < 4; ++m)
#pragma unroll
                    for (int n = 0; n < 2; ++n) acc[a][b][m][n] = (f32x4){0.f, 0.f, 0.f, 0.f};
        cur = nxt; cA = nA; cB = nB; ++ui;
        if constexpr (ALIGN_EPI) { if (wr == 1) PG8_BAR; }
    }
    PG8_WAIT_V(0);
    if constexpr (!ALIGN_EPI) { if (wr == 0) PG8_BAR; }
    PG8_BAR;
    if constexpr (Epi::AFTER_DRAIN) { E.fused(acc, cur, wr, wc, fr, fq, lds, wid, lane); S.done(cur); }
#undef PG8_SA
#undef PG8_SB
#undef PG8_STAGE
#undef PG8_LDA
#undef PG8_LDB
#undef PG8_MMA
#undef PG8_WAIT_V
#undef PG8_WAIT_L
#undef PG8_BAR
#undef PG8_SCHED
}
}

#define LAS __attribute__((address_space(3)))
typedef unsigned short bf16_t;
typedef short bf16x8 __attribute__((ext_vector_type(8)));
typedef short bf16x4 __attribute__((ext_vector_type(4)));
typedef float f32x4 __attribute__((ext_vector_type(4)));
typedef unsigned u32x4 __attribute__((ext_vector_type(4)));
typedef unsigned u32x2 __attribute__((ext_vector_type(2)));
constexpr int NB = 4, T = 4096, D = 2048, MT = NB * T, FF = 8192, PLE = 256, INW = 10256;
constexpr int ZW = 8192;
constexpr float EPS = 1e-6f;
constexpr int NWAVES = 8, NTHR = 512;
constexpr size_t MiB = (size_t)1 << 20;
constexpr size_t WS_CTL = 0, WS_PB = 1 * MiB, WS_WGLA = 9 * MiB, WS_WSB = 13 * MiB, WS_WOUT = 17 * MiB, WS_WPG = 25 * MiB, WS_WPP = 33 * MiB, WS_DEC = 34 * MiB;
constexpr int LDV = MT + 64;
constexpr size_t WS_V = 35 * MiB;
constexpr size_t WS_D = 100 * MiB;
constexpr size_t WS_XN1 = WS_D, WS_W1T = WS_D + 64 * MiB, WS_W2T = WS_D + 97 * MiB, WS_DST = WS_D, WS_MB = WS_D, WS_WUP = WS_D + 64 * MiB, WS_WDOWN = WS_D + 96 * MiB, WS_E = WS_D + 64 * MiB  , WS_XN2 = WS_V  ;
constexpr size_t WS_Z = 228 * MiB;
constexpr size_t WS_ZG = WS_Z, WS_GO = WS_Z + 32 * MiB, WS_SQ = WS_Z + 64 * MiB, WS_SK = WS_Z + 96 * MiB, WS_GAB = WS_Z + 128 * MiB, WS_GLR = WS_Z + 256 * MiB, WS_H = WS_Z;
constexpr size_t WS_END = 492 * MiB;
constexpr int LDS_BYTES = 147456, LDSCTL_OFF = 143360;
constexpr size_t WS_BAR = 16384, CTL_ZERO_BYTES = 65536;

__device__ __forceinline__ float bf2f(bf16_t h) { return __uint_as_float((unsigned)h << 16); }
__device__ __forceinline__ unsigned pk2(float lo, float hi) { return pg8::cvt_pk_bf16(lo, hi); }
__device__ __forceinline__ float wave_sum(float v) {
#pragma unroll
    for (int o = 1; o < 64; o <<= 1) v += __shfl_xor(v, o);
    return v;
}
__device__ __forceinline__ float logsig(float x) { return fminf(x, 0.f) - __logf(1.0f + __expf(-fabsf(x))); }
#define MFMA16(a, b, c) __builtin_amdgcn_mfma_f32_16x16x32_bf16((a), (b), (c), 0, 0, 0)
#define LDS_WAIT() asm volatile("s_waitcnt lgkmcnt(0)" ::: "memory")

struct Args { const float* in[18]; float* out; unsigned char* ws; int ph_lo, ph_hi, coop, pad; };

template <bool NTS> __device__ __forceinline__ void xpose_tile(const float* W, int ldw, int c0, int K, bf16_t* WT, int r0, int ncb, int item, LAS float* scr, int lane) {
    const int kb = item / ncb, nb = item % ncb, k0 = kb * 64, n0 = nb * 64;
    const float* src = W + (size_t)k0 * ldw + c0 + n0 + (lane & 15) * 4;
#pragma unroll 8
    for (int i = 0; i < 16; ++i) { const int kk = 4 * i + (lane >> 4); const f32x4 v = __builtin_nontemporal_load((const f32x4*)(src + (size_t)kk * ldw));
        LAS float* d = scr + kk * 65 + (lane & 15) * 4; d[0] = v[0]; d[1] = v[1]; d[2] = v[2]; d[3] = v[3]; }
    LDS_WAIT();
    const int c = lane & 7;
#pragma unroll
    for (int j = 0; j < 8; ++j) { const int n = (lane >> 3) + 8 * j; const LAS float* s = scr + (8 * c) * 65 + n;
        u32x4 o; o.x = pk2(s[0], s[65]); o.y = pk2(s[2 * 65], s[3 * 65]); o.z = pk2(s[4 * 65], s[5 * 65]); o.w = pk2(s[6 * 65], s[7 * 65]);
        if (NTS) __builtin_nontemporal_store(o, (u32x4*)(WT + (size_t)(r0 + n0 + n) * K + k0 + 8 * c)); else *(u32x4*)(WT + (size_t)(r0 + n0 + n) * K + k0 + 8 * c) = o; }
    LDS_WAIT();
}
struct XJob { const float* W; int ldw, c0, K, ncols; bf16_t* WT; int r0; };
template <bool NTS = false> __device__ __forceinline__ void xpose_job(const XJob& j, int& base, int gw, int NGW, LAS float* scr, int lane) {
    const int ncb = j.ncols / 64, n = (j.K / 64) * ncb;
    int it = gw - (base % NGW); if (it < 0) it += NGW;
    for (; it < n; it += NGW) xpose_tile<NTS>(j.W, j.ldw, j.c0, j.K, j.WT, j.r0, ncb, it, scr, lane);
    base += n;
}
__device__ __forceinline__ void rms_row_store(const f32x4 (&v)[8], float ss, const float* gain, bf16_t* orow, int lane) {
    const float r = rsqrtf(wave_sum(ss) * (1.f / D) + EPS);
#pragma unroll
    for (int j = 0; j < 8; ++j) { const f32x4 g = *(const f32x4*)(gain + 256 * j + 4 * lane);
        u32x2 o; o.x = pk2(v[j][0] * r * g[0], v[j][1] * r * g[1]); o.y = pk2(v[j][2] * r * g[2], v[j][3] * r * g[3]);
        *(u32x2*)(orow + 256 * j + 4 * lane) = o; }
}
__device__ __forceinline__ void p0_rows(const float* x, const float* gain, bf16_t* XN, const float* p, bf16_t* PB, int gw, int NGW, int lane) {
    for (int m0 = gw; m0 < MT; m0 += 2 * NGW) {
        const int m1 = (m0 + NGW < MT) ? m0 + NGW : m0;
        const float* xa = x + (size_t)m0 * D + 4 * lane; const float* xb = x + (size_t)m1 * D + 4 * lane; f32x4 va[8], vb[8]; float sa = 0.f, sb = 0.f;
#pragma unroll
        for (int j = 0; j < 8; ++j) va[j] = __builtin_nontemporal_load((const f32x4*)(xa + 256 * j));
#pragma unroll
        for (int j = 0; j < 8; ++j) vb[j] = __builtin_nontemporal_load((const f32x4*)(xb + 256 * j));
        const f32x4 pa = *(const f32x4*)(p + (size_t)m0 * PLE + 4 * lane), pb = *(const f32x4*)(p + (size_t)m1 * PLE + 4 * lane);
#pragma unroll
        for (int j = 0; j < 8; ++j) sa += (va[j][0] * va[j][0] + va[j][1] * va[j][1]) + (va[j][2] * va[j][2] + va[j][3] * va[j][3]);
        rms_row_store(va, sa, gain, XN + (size_t)m0 * D, lane);
#pragma unroll
        for (int j = 0; j < 8; ++j) sb += (vb[j][0] * vb[j][0] + vb[j][1] * vb[j][1]) + (vb[j][2] * vb[j][2] + vb[j][3] * vb[j][3]);
        rms_row_store(vb, sb, gain, XN + (size_t)m1 * D, lane);
        u32x2 o; o.x = pk2(pa[0], pa[1]); o.y = pk2(pa[2], pa[3]); *(u32x2*)(PB + (size_t)m0 * PLE + 4 * lane) = o;
        o.x = pk2(pb[0], pb[1]); o.y = pk2(pb[2], pb[3]); *(u32x2*)(PB + (size_t)m1 * PLE + 4 * lane) = o;
    }
}
__device__ __forceinline__ void glr_gemm(LAS unsigned char* lds, const bf16_t* XN, const float* w_in, float* GLRF, int bid, int G, int tid) {
    const int lane = tid & 63, wave = __builtin_amdgcn_readfirstlane(tid >> 6), fr = lane & 15, fq = lane >> 4;
    LAS unsigned char* WT = lds;
    LAS float* RED = (LAS float*)(lds + 65792);
    if (bid >= MT / 64) return;
#pragma unroll
    for (int i = 0; i < 16; ++i) { const int idx = tid + 512 * i, k = idx >> 2, q4 = idx & 3; const f32x4 v = *(const f32x4*)(w_in + (size_t)k * INW + 2048 + 4 * q4);
#pragma unroll
        for (int q = 0; q < 4; ++q) *(LAS bf16_t*)(WT + (4 * q4 + q) * 4112 + k * 2) = (bf16_t)(pk2(v[q], 0.f) & 0xffffu); }
    __syncthreads();
    for (int rg = bid; rg < MT / 64; rg += G) {
        const int st = wave & 3, kh = wave >> 2;
        const bf16_t* arow = XN + (size_t)(64 * rg + 16 * st + fr) * D + kh * 1024 + fq * 8;
        f32x4 acc = (f32x4){0.f, 0.f, 0.f, 0.f};
#pragma unroll 16
        for (int ks = 0; ks < 32; ++ks) { const bf16x8 a = *(const bf16x8*)(arow + ks * 32);
            const bf16x8 b = *(const LAS bf16x8*)(WT + fr * 4112 + (kh * 1024 + ks * 32 + fq * 8) * 2); acc = MFMA16(a, b, acc); }
        if (kh == 1) *(LAS f32x4*)(RED + (st * 64 + lane) * 4) = acc;
        __syncthreads();
        if (kh == 0) { const f32x4 o = acc + *(const LAS f32x4*)(RED + (st * 64 + lane) * 4);
#pragma unroll
            for (int j = 0; j < 4; ++j) GLRF[(size_t)(64 * rg + 16 * st + 4 * fq + j) * 16 + fr] = o[j]; }
        __syncthreads();
    }
}
__device__ __forceinline__ void resid_row_body(const u32x2 (&sw)[8], f32x4 (&v)[8], float* ho, const float* g_post, const float* g_next, bf16_t* xo, int lane) {
    f32x4 s[8]; float ss = 0.f;
#pragma unroll
    for (int j = 0; j < 8; ++j) { s[j][0] = pg8::bf_lo(sw[j].x); s[j][1] = pg8::bf_hi(sw[j].x); s[j][2] = pg8::bf_lo(sw[j].y); s[j][3] = pg8::bf_hi(sw[j].y);
        ss += (s[j][0] * s[j][0] + s[j][1] * s[j][1]) + (s[j][2] * s[j][2] + s[j][3] * s[j][3]); }
    const float r = rsqrtf(wave_sum(ss) * (1.f / D) + EPS); float s2 = 0.f;
#pragma unroll
    for (int j = 0; j < 8; ++j) { const f32x4 g = *(const f32x4*)(g_post + 256 * j + 4 * lane);
#pragma unroll
        for (int q = 0; q < 4; ++q) { v[j][q] += s[j][q] * r * g[q]; s2 += v[j][q] * v[j][q]; }
        *(f32x4*)(ho + 256 * j) = v[j]; }
    rms_row_store(v, s2, g_next, xo, lane);
}
__device__ __forceinline__ void resid_rows(const bf16_t* S, const float* hin, float* hout, const float* g_post, const float* g_next, bf16_t* XNo, int gw, int NGW, int lane) {
    for (int m0 = gw; m0 < MT; m0 += 2 * NGW) {
        const bool two = (m0 + NGW < MT); const int m1 = two ? m0 + NGW : m0;
        u32x2 swa[8], swb[8]; f32x4 va[8], vb[8];
#pragma unroll
        for (int j = 0; j < 8; ++j) { swa[j] = *(const u32x2*)(S + (size_t)m0 * D + 4 * lane + 256 * j); va[j] = *(const f32x4*)(hin + (size_t)m0 * D + 4 * lane + 256 * j); }
#pragma unroll
        for (int j = 0; j < 8; ++j) { swb[j] = *(const u32x2*)(S + (size_t)m1 * D + 4 * lane + 256 * j); vb[j] = *(const f32x4*)(hin + (size_t)m1 * D + 4 * lane + 256 * j); }
        resid_row_body(swa, va, hout + (size_t)m0 * D + 4 * lane, g_post, g_next, XNo + (size_t)m0 * D, lane);
        if (two) resid_row_body(swb, vb, hout + (size_t)m1 * D + 4 * lane, g_post, g_next, XNo + (size_t)m1 * D, lane);
    }
}

__device__ __forceinline__ void unpack8(const u32x2 (&w)[8], f32x4 (&s)[8], float& ss) {
    ss = 0.f;
#pragma unroll
    for (int j = 0; j < 8; ++j) { s[j][0] = pg8::bf_lo(w[j].x); s[j][1] = pg8::bf_hi(w[j].x); s[j][2] = pg8::bf_lo(w[j].y); s[j][3] = pg8::bf_hi(w[j].y);
        ss += (s[j][0] * s[j][0] + s[j][1] * s[j][1]) + (s[j][2] * s[j][2] + s[j][3] * s[j][3]); }
}
__device__ __forceinline__ void add_normed(f32x4 (&v)[8], const f32x4 (&s)[8], float ss, const float* gain, int lane, float& s2) {
    const float r = rsqrtf(wave_sum(ss) * (1.f / D) + EPS); s2 = 0.f;
#pragma unroll
    for (int j = 0; j < 8; ++j) { const f32x4 g = *(const f32x4*)(gain + 256 * j + 4 * lane);
#pragma unroll
        for (int q = 0; q < 4; ++q) { v[j][q] += s[j][q] * r * g[q]; s2 += v[j][q] * v[j][q]; } }
}
__device__ __forceinline__ void r1_rows(const bf16_t* Mb, const float* x, const float* g1, const float* gn, bf16_t* XNo, int gw, int NGW, int lane) {
    for (int m0 = gw; m0 < MT; m0 += 2 * NGW) {
        const bool two = (m0 + NGW < MT); const int m1 = two ? m0 + NGW : m0;
        u32x2 wa[8], wb[8]; f32x4 va[8], vb[8];
#pragma unroll
        for (int j = 0; j < 8; ++j) { wa[j] = *(const u32x2*)(Mb + (size_t)m0 * D + 4 * lane + 256 * j); va[j] = __builtin_nontemporal_load((const f32x4*)(x + (size_t)m0 * D + 4 * lane + 256 * j)); }
#pragma unroll
        for (int j = 0; j < 8; ++j) { wb[j] = *(const u32x2*)(Mb + (size_t)m1 * D + 4 * lane + 256 * j); vb[j] = __builtin_nontemporal_load((const f32x4*)(x + (size_t)m1 * D + 4 * lane + 256 * j)); }
        { f32x4 s[8]; float ss, s2; unpack8(wa, s, ss); add_normed(va, s, ss, g1, lane, s2); rms_row_store(va, s2, gn, XNo + (size_t)m0 * D, lane); }
        if (two) { f32x4 s[8]; float ss, s2; unpack8(wb, s, ss); add_normed(vb, s, ss, g1, lane, s2); rms_row_store(vb, s2, gn, XNo + (size_t)m1 * D, lane); }
    }
}
__device__ __forceinline__ void r2_row(const u32x2 (&wm)[8], const u32x2 (&wf)[8], f32x4 (&v)[8], const float* g1, const float* g2, const float* g3, float* ho, bf16_t* xo, int lane) {
    f32x4 s[8]; float ss, s2;
    unpack8(wm, s, ss); add_normed(v, s, ss, g1, lane, s2);
    unpack8(wf, s, ss); add_normed(v, s, ss, g2, lane, s2);
#pragma unroll
    for (int j = 0; j < 8; ++j) *(f32x4*)(ho + 256 * j) = v[j];
    rms_row_store(v, s2, g3, xo, lane);
}
__device__ __forceinline__ void r2_rows(const bf16_t* Mb, const bf16_t* Fb, const float* x, float* hout, const float* g1, const float* g2, const float* g3, bf16_t* XNo, int gw, int NGW, int lane) {
    for (int m0 = gw; m0 < MT; m0 += NGW) {
        u32x2 ma[8], fa[8]; f32x4 va[8];
#pragma unroll
        for (int j = 0; j < 8; ++j) { ma[j] = *(const u32x2*)(Mb + (size_t)m0 * D + 4 * lane + 256 * j); fa[j] = *(const u32x2*)(Fb + (size_t)m0 * D + 4 * lane + 256 * j); va[j] = *(const f32x4*)(x + (size_t)m0 * D + 4 * lane + 256 * j); }
        r2_row(ma, fa, va, g1, g2, g3, hout + (size_t)m0 * D + 4 * lane, XNo + (size_t)m0 * D, lane);
    }
}

constexpr int ATT_BUF = 64 * 272 + 128 * 144;
constexpr float ATT_RTHR = -150.1f;
template <bool MASK> __device__ __forceinline__ void attn_tile(const LAS unsigned char* Ks, const LAS unsigned char* Vs, const bf16x8 (&qf)[4], f32x4 (&oacc)[8], float& R, int s0, int tq, int fr, int fq) {
    f32x4 sacc[4];
#pragma unroll
    for (int i = 0; i < 4; ++i) { sacc[i] = (f32x4){0.f, 0.f, 0.f, 0.f};
#pragma unroll
        for (int ks = 0; ks < 4; ++ks) { const bf16x8 a = *(const LAS bf16x8*)(Ks + (16 * i + fr) * 272 + ks * 64 + fq * 16); sacc[i] = MFMA16(a, qf[ks], sacc[i]); } }
    const float sc2 = 0.08838834764831845f * 1.4426950408889634f;
    float lb[4][4], l1[4][4], tot[4], above[4];
#pragma unroll
    for (int i = 0; i < 4; ++i) {
#pragma unroll
        for (int j = 0; j < 4; ++j) { const float z = sacc[i][j] * sc2; const float lbv = fminf(z, 0.f) - __builtin_amdgcn_logf(1.0f + __builtin_amdgcn_exp2f(-fabsf(z)));
            lb[i][j] = lbv; l1[i][j] = (!MASK || (s0 + 16 * i + 4 * fq + j) < tq) ? (lbv - z) : 0.f; }
        const float g = (l1[i][0] + l1[i][1]) + (l1[i][2] + l1[i][3]);
        const float g1 = __shfl_xor(g, 16), g2 = __shfl_xor(g, 32), g3 = __shfl_xor(g, 48);
        above[i] = (((fq ^ 1) > fq) ? g1 : 0.f) + (((fq ^ 2) > fq) ? g2 : 0.f) + (((fq ^ 3) > fq) ? g3 : 0.f);
        tot[i] = (g + g1) + (g2 + g3);
    }
    float run = R; float A[4][4];
#pragma unroll
    for (int i = 3; i >= 0; --i) { const float s3 = run + above[i], s2 = s3 + l1[i][3], s1 = s2 + l1[i][2], sz = s1 + l1[i][1];
        const int kb_ = s0 + 16 * i + 4 * fq;
        A[i][3] = (!MASK || kb_ + 3 < tq) ? __builtin_amdgcn_exp2f(lb[i][3] + s3) : 0.f; A[i][2] = (!MASK || kb_ + 2 < tq) ? __builtin_amdgcn_exp2f(lb[i][2] + s2) : 0.f;
        A[i][1] = (!MASK || kb_ + 1 < tq) ? __builtin_amdgcn_exp2f(lb[i][1] + s1) : 0.f; A[i][0] = (!MASK || kb_ < tq) ? __builtin_amdgcn_exp2f(lb[i][0] + sz) : 0.f;
        run += tot[i]; }
    R = run;
#pragma unroll
    for (int s = 0; s < 2; ++s) {
        u32x4 pb; pb.x = pk2(A[2 * s][0], A[2 * s][1]); pb.y = pk2(A[2 * s][2], A[2 * s][3]); pb.z = pk2(A[2 * s + 1][0], A[2 * s + 1][1]); pb.w = pk2(A[2 * s + 1][2], A[2 * s + 1][3]);
        const bf16x8 bfrag = __builtin_bit_cast(bf16x8, pb);
#pragma unroll
        for (int di = 0; di < 8; ++di) { const LAS unsigned char* vp = Vs + (16 * di + fr) * 144 + (32 * s + 4 * fq) * 2;
            const u32x2 lo = *(const LAS u32x2*)vp, hi = *(const LAS u32x2*)(vp + 32);
            u32x4 av; av.x = lo.x; av.y = lo.y; av.z = hi.x; av.w = hi.y;
            oacc[di] = MFMA16(__builtin_bit_cast(bf16x8, av), bfrag, oacc[di]); }
    }
}
__device__ __forceinline__ void attn_unit(LAS unsigned char* lds, bf16_t* SQ, bf16_t* OUTB, const bf16_t* SK, const bf16_t* VT, int b, int h, int qb, int tid) {
    const int lane = tid & 63, w = __builtin_amdgcn_readfirstlane(tid >> 6), fr = lane & 15, fq = lane >> 4;
    LAS unsigned char* Ks = lds;
    LAS unsigned char* Vs = lds + 64 * 272;
    const int tw0 = qb * 128 + w * 16;
    bf16_t* qrow = SQ + (size_t)(b * T + tw0 + fr) * 1024 + h * 128;
    bf16x8 qf[4];
#pragma unroll
    for (int ks = 0; ks < 4; ++ks) qf[ks] = *(const bf16x8*)(qrow + ks * 32 + fq * 8);
    f32x4 oacc[8];
#pragma unroll
    for (int i = 0; i < 8; ++i) oacc[i] = (f32x4){0.f, 0.f, 0.f, 0.f};
    float R = 0.f;
    const int nkt = 2 * qb + 2;
    const bf16_t* kbase = SK + (size_t)(b * T) * 1024 + h * 128;
    const bf16_t* vbase = VT + (size_t)(1024 + h * 128) * LDV + (size_t)b * T;
    u32x4 ak[2], av[2], bk[2], bv[2];
#define ATT_PREFETCH(RK, RV, kt) do { _Pragma("unroll") for (int i_ = 0; i_ < 2; ++i_) { const int idx_ = tid + 512 * i_; \
        RK[i_] = *(const u32x4*)(kbase + (size_t)((kt) * 64 + (idx_ >> 4)) * 1024 + (idx_ & 15) * 8); \
        RV[i_] = *(const u32x4*)(vbase + (size_t)(idx_ >> 3) * LDV + (kt) * 64 + (idx_ & 7) * 8); } } while (0)
#define ATT_WRITE(RK, RV, pp) do { _Pragma("unroll") for (int i_ = 0; i_ < 2; ++i_) { const int idx_ = tid + 512 * i_; \
        *(LAS u32x4*)(Ks + (pp) * ATT_BUF + (idx_ >> 4) * 272 + (idx_ & 15) * 16) = RK[i_]; \
        *(LAS u32x4*)(Vs + (pp) * ATT_BUF + (idx_ >> 3) * 144 + (idx_ & 7) * 16) = RV[i_]; } } while (0)
#define ATT_STEP(T, P, RK, RV) { const int t_ = (T); const int s0 = t_ * 64; \
        const bool wdone = __builtin_amdgcn_ballot_w64(R < ATT_RTHR) == ~0ull; \
        if (s0 <= tw0 && !wdone) { \
            if (s0 + 63 < tw0) attn_tile<false>(Ks + (P) * ATT_BUF, Vs + (P) * ATT_BUF, qf, oacc, R, s0, tw0 + fr, fr, fq); \
            else attn_tile<true>(Ks + (P) * ATT_BUF, Vs + (P) * ATT_BUF, qf, oacc, R, s0, tw0 + fr, fr, fq); } \
        if (t_ > 0) { ATT_WRITE(RK, RV, (P) ^ 1); if (t_ > 2) ATT_PREFETCH(RK, RV, t_ - 3); } \
        const bool live = __builtin_amdgcn_ballot_w64(R < ATT_RTHR) != ~0ull; const int vn = (vw == 2) ? 0 : vw + 1; \
        if (live && lane == 0) vote[vw] = 1u; \
        if (tid == 0) vote[vn] = 0u; \
        __syncthreads(); \
        if (vote[vw] == 0u || t_ == 0) break; \
        vw = vn; }
    volatile LAS unsigned* vote = (volatile LAS unsigned*)(lds + 2 * ATT_BUF);
    ATT_PREFETCH(ak, av, nkt - 1);
    ATT_WRITE(ak, av, 0);
    ATT_PREFETCH(ak, av, nkt - 2);
    if (nkt > 2) ATT_PREFETCH(bk, bv, nkt - 3);
    if (tid < 3) vote[tid] = 0u;
    __syncthreads();
    int vw = 0;
    for (int kt = nkt - 1; ; kt -= 2) {
        ATT_STEP(kt, 0, ak, av)
        ATT_STEP(kt - 1, 1, bk, bv)
    }
#undef ATT_STEP
#undef ATT_WRITE
#undef ATT_PREFETCH
#pragma unroll
    for (int di = 0; di < 8; ++di) { u32x2 o; o.x = pk2(oacc[di][0], oacc[di][1]); o.y = pk2(oacc[di][2], oacc[di][3]);
        *(u32x2*)(OUTB + (size_t)(b * T + tw0 + fr) * 1024 + h * 128 + 16 * di + 4 * fq) = o; }
    __syncthreads();
}

__device__ __forceinline__ void gla_cumdecay(LAS unsigned char* scr, const float* GLR, const float* Wg, const float* bg, int r0, int h, int tid, float (&bcum)[16], float& blast) {
    LAS float* sG = (LAS float*)scr;
    LAS float* sTot = (LAS float*)(scr + 4096);
    const int d = tid & 127, tg = tid >> 7;
#pragma unroll
    for (int i = 0; i < 2; ++i) { const int e = tid + 512 * i; sG[e] = GLR[(size_t)r0 * 16 + e]; }
    float wg[16];
#pragma unroll
    for (int r = 0; r < 16; ++r) wg[r] = Wg[r * 512 + h * 128 + d];
    const float bias = bg[h * 128 + d];
    __syncthreads();
    float run = 0.f;
#pragma unroll
    for (int i = 0; i < 16; ++i) { const LAS float* g = sG + (tg * 16 + i) * 16; float x = bias;
#pragma unroll
        for (int r = 0; r < 16; ++r) x += g[r] * wg[r];
        run += logsig(x) * (1.0f / 16.0f); bcum[i] = run; }
    sTot[tg * 128 + d] = run;
    __syncthreads();
    float pre = 0.f, all = 0.f;
#pragma unroll
    for (int g = 0; g < 4; ++g) { const float v = sTot[g * 128 + d]; all += v; if (g < tg) pre += v; }
#pragma unroll
    for (int i = 0; i < 16; ++i) bcum[i] += pre;
    blast = all;
}
__device__ __forceinline__ void gla_pass_a(LAS unsigned char* lds, const bf16_t* ZG, const float* GLR, const bf16_t* VT, const float* Wg, const float* bg, bf16_t* DST, float* DEC, int item, int tid) {
    const int bh = item >> 6, n = item & 63, b = bh >> 2, h = bh & 3, r0 = b * T + n * 64;
    const int lane = tid & 63, w = __builtin_amdgcn_readfirstlane(tid >> 6), fr = lane & 15, fq = lane >> 4, d = tid & 127, tg = tid >> 7;
    LAS unsigned char* KsT = lds;
    LAS unsigned char* scr = lds + 128 * 144;
    float bcum[16], blast;
    bf16_t kraw[16];
#pragma unroll
    for (int i = 0; i < 16; ++i) kraw[i] = ZG[(size_t)(r0 + tg * 16 + i) * 1024 + 512 + h * 128 + d];
    gla_cumdecay(scr, GLR, Wg, bg, r0, h, tid, bcum, blast);
    unsigned pk[8];
#pragma unroll
    for (int i = 0; i < 16; i += 2) { const float k0 = bf2f(kraw[i]), k1 = bf2f(kraw[i + 1]);
        pk[i >> 1] = pk2(k0 * __expf(blast - bcum[i]), k1 * __expf(blast - bcum[i + 1])); }
    *(LAS u32x4*)(KsT + d * 144 + tg * 32) = (u32x4){pk[0], pk[1], pk[2], pk[3]};
    *(LAS u32x4*)(KsT + d * 144 + tg * 32 + 16) = (u32x4){pk[4], pk[5], pk[6], pk[7]};
    if (tg == 0) DEC[item * 128 + d] = __expf(blast);
    __syncthreads();
    const bf16_t* vt = VT + (size_t)(h * 256) * LDV + r0;
    bf16_t* dst = DST + (size_t)item * 32768;
#pragma unroll
    for (int ee = 0; ee < 2; ++ee) { const int ei = 2 * w + ee;
        bf16x8 vb[2];
#pragma unroll
        for (int ks = 0; ks < 2; ++ks) vb[ks] = *(const bf16x8*)(vt + (size_t)(16 * ei + fr) * LDV + ks * 32 + fq * 8);
#pragma unroll
        for (int di = 0; di < 8; ++di) { f32x4 acc = (f32x4){0.f, 0.f, 0.f, 0.f};
#pragma unroll
            for (int ks = 0; ks < 2; ++ks) { const bf16x8 a = *(const LAS bf16x8*)(KsT + (16 * di + fr) * 144 + ks * 64 + fq * 16); acc = MFMA16(a, vb[ks], acc); }
            u32x2 o; o.x = pk2(acc[0], acc[1]); o.y = pk2(acc[2], acc[3]);
            *(u32x2*)(dst + (size_t)(16 * ei + fr) * 128 + 16 * di + 4 * fq) = o; }
    }
    __syncthreads();
}
__device__ __forceinline__ void gla_pass_b(bf16_t* DST, const float* DEC, int gtid, int nthreads) {
    for (int idx = gtid; idx < 16 * 256 * 32; idx += nthreads) {
        const int d4 = idx & 31, e = (idx >> 5) & 255, bh = idx >> 13;
        bf16_t* p = DST + (size_t)(bh * 64) * 32768 + e * 128 + d4 * 4; const float* dc = DEC + (size_t)(bh * 64) * 128 + d4 * 4;
        f32x4 S = (f32x4){0.f, 0.f, 0.f, 0.f};
#pragma unroll 9
        for (int n = 0; n < 63; ++n) { const u32x2 w = *(const u32x2*)(p + (size_t)n * 32768); const f32x4 dd = *(const f32x4*)(dc + n * 128);
            const f32x4 v = (f32x4){pg8::bf_lo(w.x), pg8::bf_hi(w.x), pg8::bf_lo(w.y), pg8::bf_hi(w.y)};
            S = dd * S + v; u32x2 o; o.x = pk2(S[0], S[1]); o.y = pk2(S[2], S[3]); *(u32x2*)(p + (size_t)n * 32768) = o; }
    }
}
__device__ __forceinline__ void gla_pass_c(LAS unsigned char* lds, const bf16_t* ZG, const float* GLR, const bf16_t* VT, const float* Wg, const float* bg, const bf16_t* DST, const float* gn, bf16_t* GO, int item, int tid) {
    const int bh = item >> 6, n = item & 63, b = bh >> 2, h = bh & 3, r0 = b * T + n * 64;
    const int lane = tid & 63, w = __builtin_amdgcn_readfirstlane(tid >> 6), fr = lane & 15, fq = lane >> 4, d = tid & 127, tg = tid >> 7;
    LAS unsigned char* Qd = lds;
    LAS unsigned char* Ki = lds + 17408;
    LAS unsigned char* P = lds + 34816;
    LAS float* sSS = (LAS float*)(lds + 44032);
    LAS unsigned char* scr = lds + 45056;
    float bcum[16], blast;
    bf16_t qraw[16], kraw[16];
#pragma unroll
    for (int i = 0; i < 16; ++i) { const bf16_t* zr = ZG + (size_t)(r0 + tg * 16 + i) * 1024 + h * 128 + d; qraw[i] = zr[0]; kraw[i] = zr[512]; }
    gla_cumdecay(scr, GLR, Wg, bg, r0, h, tid, bcum, blast);
#pragma unroll
    for (int i = 0; i < 16; ++i) { const int t = tg * 16 + i;
        const float q = bf2f(qraw[i]), k = bf2f(kraw[i]);
        *(LAS bf16_t*)(Qd + t * 272 + d * 2) = (bf16_t)(pk2(q * 0.08838834764831845f * __expf(bcum[i]), 0.f) & 0xffffu);
        *(LAS bf16_t*)(Ki + t * 272 + d * 2) = (bf16_t)(pk2(k * __expf(-bcum[i]), 0.f) & 0xffffu); }
    __syncthreads();
    const int ti = w >> 1;
    {
#pragma unroll
        for (int ss = 0; ss < 2; ++ss) { const int si = 2 * (w & 1) + ss; f32x4 acc = (f32x4){0.f, 0.f, 0.f, 0.f};
            if (si <= ti) {
#pragma unroll
                for (int ks = 0; ks < 4; ++ks) { const bf16x8 a = *(const LAS bf16x8*)(Ki + (16 * si + fr) * 272 + ks * 64 + fq * 16), bq = *(const LAS bf16x8*)(Qd + (16 * ti + fr) * 272 + ks * 64 + fq * 16);
                    acc = MFMA16(a, bq, acc); } }
            const int tt = 16 * ti + fr, sb = 16 * si + 4 * fq;
            u32x2 o; o.x = pk2(sb <= tt ? acc[0] : 0.f, sb + 1 <= tt ? acc[1] : 0.f); o.y = pk2(sb + 2 <= tt ? acc[2] : 0.f, sb + 3 <= tt ? acc[3] : 0.f);
            *(LAS u32x2*)(P + tt * 144 + sb * 2) = o; }
    }
    __syncthreads();
    const int eh = w & 1;
    bf16x8 pf[2], qf[4];
#pragma unroll
    for (int ks = 0; ks < 2; ++ks) pf[ks] = *(const LAS bf16x8*)(P + (16 * ti + fr) * 144 + ks * 64 + fq * 16);
#pragma unroll
    for (int ks = 0; ks < 4; ++ks) qf[ks] = *(const LAS bf16x8*)(Qd + (16 * ti + fr) * 272 + ks * 64 + fq * 16);
    const bf16_t* vt = VT + (size_t)(h * 256) * LDV + r0;
    const bf16_t* sp = DST + (size_t)(item - 1) * 32768;
    f32x4 acc[8]; float ssq = 0.f;
#pragma unroll
    for (int e8 = 0; e8 < 8; ++e8) { const int ei = 8 * eh + e8; acc[e8] = (f32x4){0.f, 0.f, 0.f, 0.f};
#pragma unroll
        for (int ks = 0; ks < 2; ++ks) { const bf16x8 a = *(const bf16x8*)(vt + (size_t)(16 * ei + fr) * LDV + ks * 32 + fq * 8); acc[e8] = MFMA16(a, pf[ks], acc[e8]); }
        if (n > 0) {
#pragma unroll
            for (int ks = 0; ks < 4; ++ks) { const bf16x8 av = *(const bf16x8*)(sp + (size_t)(16 * ei + fr) * 128 + ks * 32 + fq * 8);
                acc[e8] = MFMA16(av, qf[ks], acc[e8]); } }
        ssq += (acc[e8][0] * acc[e8][0] + acc[e8][1] * acc[e8][1]) + (acc[e8][2] * acc[e8][2] + acc[e8][3] * acc[e8][3]);
    }
    ssq += __shfl_xor(ssq, 16); ssq += __shfl_xor(ssq, 32);
    if (fq == 0) sSS[eh * 64 + 16 * ti + fr] = ssq;
    __syncthreads();
    const float rn = rsqrtf((sSS[16 * ti + fr] + sSS[64 + 16 * ti + fr]) * (1.0f / 256.0f) + EPS);
    bf16_t* gor = GO + (size_t)(r0 + 16 * ti + fr) * 1024 + h * 256;
#pragma unroll
    for (int e8 = 0; e8 < 8; ++e8) { const int e0 = 16 * (8 * eh + e8) + 4 * fq; const f32x4 g = *(const f32x4*)(gn + e0);
        const u32x2 gw = *(const u32x2*)(gor + e0); const float x0 = pg8::bf_lo(gw.x), x1 = pg8::bf_hi(gw.x), x2 = pg8::bf_lo(gw.y), x3 = pg8::bf_hi(gw.y);
        u32x2 o; o.x = pk2(acc[e8][0] * rn * g[0] * x0 * pg8::sigm(x0), acc[e8][1] * rn * g[1] * x1 * pg8::sigm(x1));
        o.y = pk2(acc[e8][2] * rn * g[2] * x2 * pg8::sigm(x2), acc[e8][3] * rn * g[3] * x3 * pg8::sigm(x3));
        *(u32x2*)(gor + e0) = o; }
    __syncthreads();
}
#define XB_TMO      128
#define XB_XCNT(j)  (256  + 64 * (j))
#define XB_XSUB(j)  (1280 + 64 * (j))
#define XB_XGEN(j)  (2304 + 64 * (j))
#define XB_TOP      3328
#define XB_TOPGEN   3392
#define XCD_BAR_WORDS 3456
#define XB_SPIN_CAP (1u << 18)

__device__ __forceinline__ unsigned xb_ld(unsigned* p)              { return __hip_atomic_load(p, __ATOMIC_RELAXED, __HIP_MEMORY_SCOPE_AGENT); }
__device__ __forceinline__ unsigned xb_add(unsigned* p, unsigned v) { return __hip_atomic_fetch_add(p, v, __ATOMIC_RELAXED, __HIP_MEMORY_SCOPE_AGENT); }
__device__ __forceinline__ unsigned xb_xcc_id() { return (unsigned)__builtin_amdgcn_s_getreg((3 << 11) | 20) & 0xFu; }
#define XB_SPIN(cond, bar) do { unsigned _sp = 0; while (cond) { __builtin_amdgcn_s_sleep(1); \
    if ((++_sp & 255u) == 0u) { if (xb_ld(&(bar)[XB_TMO])) break; if (_sp > XB_SPIN_CAP) { atomicAdd(&(bar)[XB_TMO], 1u); break; } } } } while (0)

struct XcdBarrier {
    unsigned* bar; unsigned x;
    volatile LAS unsigned* st;
};

__device__ __forceinline__ XcdBarrier xcd_barrier_post(unsigned* bar, volatile LAS unsigned* st) {
    XcdBarrier b; b.bar = bar; b.x = xb_xcc_id(); b.st = st;
    if (threadIdx.x == 0) (void)xb_add(&bar[XB_XCNT(b.x)], 1u);
    return b;
}
__device__ __forceinline__ void xcd_barrier_complete(unsigned* bar, unsigned x, unsigned& nloc, unsigned& nx) {
    const unsigned G = gridDim.x * gridDim.y * gridDim.z;
    unsigned sum, cnt, mine, sp = 0u;
    for (;;) {
        sum = 0u; cnt = 0u; mine = 0u;
#pragma unroll
        for (unsigned j = 0; j < 16; ++j) { const unsigned c = xb_ld(&bar[XB_XCNT(j)]); sum += c; cnt += (c > 0u) ? 1u : 0u; mine = (j == x) ? c : mine; }
        if (sum == G) break;
        __builtin_amdgcn_s_sleep(1);
        if ((++sp & 255u) == 0u) { if (xb_ld(&bar[XB_TMO])) break; if (sp > XB_SPIN_CAP) { atomicAdd(&bar[XB_TMO], 1u); break; } }
    }
    nloc = mine > 0u ? mine : 1u; nx = cnt > 0u ? cnt : 1u;
}

__device__ __forceinline__ void xcd_barrier(const XcdBarrier& b) {
    asm volatile("s_waitcnt vmcnt(0)" ::: "memory");
    __syncthreads();
    if (threadIdx.x == 0) {
        unsigned* bar = b.bar;
        __builtin_amdgcn_s_waitcnt(0);
        unsigned nloc = b.st[0], nx = b.st[1];
        if (nloc == 0u) { xcd_barrier_complete(bar, b.x, nloc, nx); b.st[0] = nloc; b.st[1] = nx; }
        const unsigned old = xb_add(&bar[XB_XSUB(b.x)], 1u);
        const unsigned gen = old / nloc;
        if (old + 1u == (gen + 1u) * nloc) {
            __builtin_amdgcn_fence(__ATOMIC_RELEASE, "agent");
            asm volatile("s_waitcnt vmcnt(0)" ::: "memory");
            const unsigned og = xb_add(&bar[XB_TOP], 1u);
            const unsigned tg = og / nx;
            if (og + 1u == (tg + 1u) * nx) xb_add(&bar[XB_TOPGEN], 1u);
            else XB_SPIN(xb_ld(&bar[XB_TOPGEN]) == tg, bar);
            __builtin_amdgcn_fence(__ATOMIC_ACQUIRE, "agent");
            xb_add(&bar[XB_XGEN(b.x)], 1u);
            asm volatile("s_waitcnt vmcnt(0)" ::: "memory");
        } else {
            XB_SPIN(xb_ld(&bar[XB_XGEN(b.x)]) == gen, bar);
            __builtin_amdgcn_fence(__ATOMIC_ACQUIRE, "agent");
            asm volatile("s_waitcnt vmcnt(0)" ::: "memory");
        }
    }
    __syncthreads();
}

#ifndef MK_SPLIT
#define MK_SPLIT 0
#endif
constexpr int N_PHASES = 12;
__global__ void __launch_bounds__(NTHR, 2) fwd_kernel(Args args) {
    extern __shared__ __attribute__((aligned(16))) unsigned char lds_raw[];
    LAS unsigned char* lds = (LAS unsigned char*)lds_raw;
    const int tid = threadIdx.x, lane = tid & 63, wave = __builtin_amdgcn_readfirstlane(tid >> 6);
    const int G = gridDim.x, bid = blockIdx.x;
    const int gw = bid * NWAVES + wave, NGW = G * NWAVES;
    unsigned char* ws = args.ws;
    const float* x = args.in[0]; const float* p = args.in[1]; const float* g_mix_pre = args.in[2]; const float* g_mix_post = args.in[3];
    const float* w_in = args.in[4]; const float* w_gate_up = args.in[5]; const float* b_gate = args.in[6]; const float* gla_norm = args.in[7];
    const float* w_bgla = args.in[8]; const float* w_bsb = args.in[9]; const float* w_out = args.in[10]; const float* g_mlp_pre = args.in[11];
    const float* g_mlp_post = args.in[12]; const float* w_up = args.in[13]; const float* w_down = args.in[14]; const float* g_ple = args.in[15];
    const float* w_pg = args.in[16]; const float* w_pp = args.in[17]; float* out = args.out;
    bf16_t* PB = (bf16_t*)(ws + WS_PB); bf16_t* WGLA = (bf16_t*)(ws + WS_WGLA); bf16_t* WSB = (bf16_t*)(ws + WS_WSB); bf16_t* WOUT = (bf16_t*)(ws + WS_WOUT);
    bf16_t* WPG = (bf16_t*)(ws + WS_WPG); bf16_t* WPP = (bf16_t*)(ws + WS_WPP); float* DEC = (float*)(ws + WS_DEC);
    bf16_t* VT = (bf16_t*)(ws + WS_V); bf16_t* Y = (bf16_t*)(ws + WS_V); bf16_t* FB = (bf16_t*)(ws + WS_V);
    bf16_t* XN1 = (bf16_t*)(ws + WS_XN1); bf16_t* W1T = (bf16_t*)(ws + WS_W1T); bf16_t* W2T = (bf16_t*)(ws + WS_W2T); bf16_t* DST = (bf16_t*)(ws + WS_DST);
    bf16_t* MB = (bf16_t*)(ws + WS_MB); bf16_t* WUP = (bf16_t*)(ws + WS_WUP); bf16_t* WDOWN = (bf16_t*)(ws + WS_WDOWN); bf16_t* EB = (bf16_t*)(ws + WS_E); bf16_t* XN2 = (bf16_t*)(ws + WS_XN2);
    bf16_t* ZG = (bf16_t*)(ws + WS_ZG); bf16_t* GO = (bf16_t*)(ws + WS_GO); bf16_t* SQ = (bf16_t*)(ws + WS_SQ); bf16_t* SK = (bf16_t*)(ws + WS_SK);
    bf16_t* GAB = (bf16_t*)(ws + WS_GAB); float* GLR = (float*)(ws + WS_GLR); bf16_t* HB = (bf16_t*)(ws + WS_H);
    const int lo = args.ph_lo, hi = args.ph_hi;
#define IN(k) (lo <= (k) && (k) < hi)
#define SEAM(k) do { if (IN(k) && IN((k) + 1)) { xcd_barrier(bar); } } while (0)
    if (args.coop == 2) cg::this_grid().sync();
    if (tid < 32) ((LAS unsigned*)(lds + LDSCTL_OFF))[tid] = 0u;
    __syncthreads();
    const XcdBarrier bar = xcd_barrier_post((unsigned*)(ws + WS_BAR), (volatile LAS unsigned*)(lds + LDSCTL_OFF));
    LAS float* xscr = (LAS float*)(lds + wave * 16640);

    if (IN(0)) {
        int base = 0;
        const XJob jobs[14] = {
            {w_in, INW, 0, D, 512, W1T, 0}, {w_in, INW, 512, D, 512, W1T, 512}, {w_in, INW, 2064, D, 1024, W1T, 1024}, {w_in, INW, 3088, D, 1024, W1T, 2048},
            {w_in, INW, 4112, D, 1024, W1T, 3072}, {w_in, INW, 6160, D, 2048, W1T, 4096}, {w_in, INW, 8208, D, 2048, W1T, 6144},
            {w_in, INW, 1024, D, 1024, W2T, 0}, {w_in, INW, 5136, D, 1024, W2T, 1024},
            {w_bgla, D, 0, 1024, D, WGLA, 0}, {w_bsb, D, 0, 1024, D, WSB, 0}, {w_out, D, 0, D, D, WOUT, 0}, {w_pg, D, 0, D, D, WPG, 0}, {w_pp, D, 0, PLE, D, WPP, 0} };
#pragma unroll
        for (int j = 0; j < 14; ++j) xpose_job(jobs[j], base, gw, NGW, xscr, lane);
        p0_rows(x, g_mix_pre, XN1, p, PB, gw, NGW, lane);
    }
    SEAM(0);
    if (IN(1)) {
        { pg8::Gemm g{XN1, W1T, MT, ZW, D}; pg8::StaticOrder S; S.init(MT, ZW, G, bid); pg8::Epi<pg8::EP_SPLIT> E{ZG, 0, nullptr, 0, nullptr};
          pg8::gemm_phase<pg8::Epi<pg8::EP_SPLIT>, pg8::StaticOrder, true, true>(lds, g, S, E); }
        { pg8::Gemm g{W2T, XN1, 2048, MT, D}; pg8::StaticOrder S; S.init(2048, MT, G, bid); pg8::Epi<pg8::EP_STORE> E{VT, LDV, nullptr, 0, nullptr};
          pg8::gemm_phase<pg8::Epi<pg8::EP_STORE>, pg8::StaticOrder, true, true>(lds, g, S, E); }
        glr_gemm(lds, XN1, w_in, GLR, bid, G, tid);
    }
    SEAM(1);
    if (IN(2)) {
        const int role = (bid >> 3) & 3;
#pragma unroll 1
        for (int s = 0; s < 4; ++s) {
            if (s == role) { __syncthreads(); int base = 0; const XJob j0{w_up, FF, 0, D, FF, WUP, 0}, j1{w_down, D, 0, FF, D, WDOWN, 0};
                xpose_job<true>(j0, base, gw, NGW, xscr, lane); xpose_job<true>(j1, base, gw, NGW, xscr, lane); __syncthreads(); }
            if (s < 2) {
                for (int i = 2 * s; (s == 0 ? i < 2 : true) && i * G + bid < 1024; ++i) { int j = i * G + bid; if ((i & 1) && (i + 1) * G <= 1024) j = (i + 1) * G - 1 - bid;
                    const int qb = 31 - (j >> 5), bh = j & 31; attn_unit(lds, SQ, SQ, SK, VT, bh >> 3, bh & 7, qb, tid); }
            } else if (s == 2) {
                for (int it = bid; it < 1024; it += G) gla_pass_a(lds, ZG, GLR, VT, w_gate_up, b_gate, DST, DEC, it, tid);
            }
        }
    }
    SEAM(2);
    if (IN(3)) gla_pass_b(DST, DEC, bid * NTHR + tid, G * NTHR);
    SEAM(3);
    if (IN(4)) { for (int it = bid; it < 1024; it += G) gla_pass_c(lds, ZG, GLR, VT, w_gate_up, b_gate, DST, gla_norm, GO, it, tid); }
    SEAM(4);
    if (IN(5)) {
        { pg8::Gemm g{GO, WGLA, MT, D, 1024}; pg8::StaticOrder S; S.init(MT, D, G, bid); pg8::Epi<pg8::EP_GATE1> E{Y, D, GAB, 4096, nullptr};
          pg8::gemm_phase<pg8::Epi<pg8::EP_GATE1>, pg8::StaticOrder, false, true>(lds, g, S, E); }
        { pg8::Gemm g{SQ, WSB, MT, D, 1024}; pg8::StaticOrder S; S.init(MT, D, G, bid); pg8::Epi<pg8::EP_GATE2> E{Y, D, GAB + 2048, 4096, nullptr};
          pg8::gemm_phase<pg8::Epi<pg8::EP_GATE2>, pg8::StaticOrder, false, true>(lds, g, S, E); }
    }
    SEAM(5);
    if (IN(6)) { pg8::Gemm g{Y, WOUT, MT, D, D}; pg8::StaticOrder S; S.init(MT, D, G, bid); pg8::Epi<pg8::EP_STORE> E{MB, D, nullptr, 0, nullptr};
        pg8::gemm_phase<pg8::Epi<pg8::EP_STORE>, pg8::StaticOrder, true, true>(lds, g, S, E); }
    SEAM(6);
    if (IN(7)) {
        r1_rows(MB, x, g_mix_post, g_mlp_pre, XN2, gw, NGW, lane);
    }
    SEAM(7);
    if (IN(8)) { pg8::Gemm g{XN2, WUP, MT, FF, D}; pg8::StaticOrder S; S.init(MT, FF, G, bid); pg8::Epi<pg8::EP_RELU2> E{HB, FF, nullptr, 0, nullptr};
        pg8::gemm_phase<pg8::Epi<pg8::EP_RELU2>, pg8::StaticOrder, true, true>(lds, g, S, E); }
    SEAM(8);
    if (IN(9)) { pg8::Gemm g{HB, WDOWN, MT, D, FF}; pg8::StaticOrder S; S.init(MT, D, G, bid); pg8::Epi<pg8::EP_STORE> E{FB, D, nullptr, 0, nullptr};
        pg8::gemm_phase<pg8::Epi<pg8::EP_STORE>, pg8::StaticOrder, true, true>(lds, g, S, E); }
    SEAM(9);
    if (IN(10)) {
        if ((bid >> 3) & 1) r2_rows(MB, FB, x, out, g_mix_post, g_mlp_post, g_ple, FB, gw, NGW, lane);
        __syncthreads();
        { pg8::Gemm g{PB, WPP, MT, D, PLE}; pg8::StaticOrder S; S.init(MT, D, G, bid); pg8::Epi<pg8::EP_STORE> E{EB, D, nullptr, 0, nullptr};
          pg8::gemm_phase<pg8::Epi<pg8::EP_STORE>, pg8::StaticOrder, true, true>(lds, g, S, E); }
        __syncthreads();
        if (!((bid >> 3) & 1)) r2_rows(MB, FB, x, out, g_mix_post, g_mlp_post, g_ple, FB, gw, NGW, lane);
    }
    SEAM(10);
    if (IN(11)) {
        { pg8::Gemm g{FB, WPG, MT, D, D}; pg8::StaticOrder S; S.init(MT, D, G, bid); pg8::Epi<pg8::EP_FINAL> E{nullptr, D, EB, D, out};
          pg8::gemm_phase<pg8::Epi<pg8::EP_FINAL>, pg8::StaticOrder, false, true>(lds, g, S, E); }
    }
#undef IN
#undef SEAM
}

extern "C" void kernel_launch(void* const* d_in, const int* in_sizes, int n_in, void* d_out, int out_size, void* d_ws, size_t ws_size, hipStream_t stream) {
    static int grid = 0;
    if (grid == 0) {
        if (n_in != 18 || in_sizes[0] != MT * D || out_size != MT * D || ws_size < WS_END) { fprintf(stderr, "kernel_launch: unexpected shapes (n_in %d, in0 %d, out %d, ws %zu)\n", n_in, n_in > 0 ? in_sizes[0] : -1, out_size, ws_size); grid = -1; return; }
        int dev = 0, cus = 0, per_cu = 0;
        if (hipGetDevice(&dev) != hipSuccess || hipDeviceGetAttribute(&cus, hipDeviceAttributeMultiprocessorCount, dev) != hipSuccess) { grid = -1; return; }
        if (hipFuncSetAttribute((const void*)fwd_kernel, hipFuncAttributeMaxDynamicSharedMemorySize, LDS_BYTES) != hipSuccess) { fprintf(stderr, "kernel_launch: hipFuncSetAttribute failed\n"); grid = -1; return; }
        if (hipOccupancyMaxActiveBlocksPerMultiprocessor(&per_cu, (const void*)fwd_kernel, NTHR, LDS_BYTES) != hipSuccess || per_cu < 1) { fprintf(stderr, "kernel_launch: occupancy query gave %d\n", per_cu); per_cu = 1; }
        (void)hipGetLastError();
        grid = cus;
    }
    if (grid < 0) return;
    if (hipMemsetAsync((char*)d_ws + WS_CTL, 0, CTL_ZERO_BYTES, stream) != hipSuccess) { fprintf(stderr, "kernel_launch: memset failed\n"); return; }
    Args a{};
    for (int i = 0; i < 18; ++i) a.in[i] = (const float*)d_in[i];
    a.out = (float*)d_out; a.ws = (unsigned char*)d_ws;
#if MK_SPLIT
    for (int ph = 0; ph < N_PHASES; ++ph) { a.ph_lo = ph; a.ph_hi = ph + 1; a.coop = 0;
        hipLaunchKernelGGL(fwd_kernel, dim3(grid), dim3(NTHR), LDS_BYTES, stream, a); }
#else
    a.ph_lo = 0; a.ph_hi = N_PHASES; a.coop = 1;
    void* kargs[] = {&a};
    const hipError_t e = hipLaunchCooperativeKernel((const void*)fwd_kernel, dim3(grid), dim3(NTHR), kargs, LDS_BYTES, stream);
    if (e != hipSuccess) fprintf(stderr, "kernel_launch: cooperative launch failed: %s (grid %d)\n", hipGetErrorString(e), grid);
#endif
}
```
